# Optimizing an MI355X kernel written in HIP

```python
import jax
import jax.numpy as jnp
from jax import lax
import numpy as np

D_MODEL = 2048
BATCH = 2
SEQ = 8192
DEPTH = 4

N_EVEN = (DEPTH + 1) // 2
N_ODD = DEPTH // 2

CONV_CH = D_MODEL // 2
CONV_WIDTH = 3
ATT_HEADS = 8
ATT_HEAD_DIM = (D_MODEL // 2) // ATT_HEADS
ATT_WIDTH = ATT_HEADS * ATT_HEAD_DIM
DILATED_PAIRS = ((128, 1), (512, 4), (2048, 16))
ROPE_THETA = 10000.0
EVEN_IN = 3 * CONV_CH + 3 * ATT_WIDTH
MLSTM_HEADS = 8
MLSTM_QK_DIM = 128
MLSTM_V_DIM = D_MODEL // MLSTM_HEADS
MLSTM_CHUNK = 128
FORGET_BIAS_INIT = 3.0
ODD_IN = 2 * MLSTM_HEADS * MLSTM_QK_DIM + 2 * MLSTM_HEADS * MLSTM_V_DIM + 2 * MLSTM_HEADS
PEER_HEADS = 8
PEER_NKEYS = 128
PEER_QDIM = 256
PEER_TOPK = 16
PEER_EXPERTS = PEER_NKEYS * PEER_NKEYS
PEER_TOKEN_BLOCK = 128
PLE_DIM = 256
POS_OFFSET_MAX = 1024
ALPHA = (2.0 * DEPTH) ** 0.25
BETA = (8.0 * DEPTH) ** -0.25
LN_EPS = 1e-5

kernel_name = 'hybrid_conv_dilattn_mlstm_peer_deepnorm'


def _layer_norm(x, gain, bias):
    xf = x.astype(jnp.float32)
    mu = jnp.mean(xf, axis=-1, keepdims=True)
    var = jnp.mean(jnp.square(xf - mu), axis=-1, keepdims=True)
    y = (xf - mu) * lax.rsqrt(var + LN_EPS) * gain.astype(jnp.float32) + bias.astype(jnp.float32)
    return y.astype(x.dtype)


def _rope(t, positions):
    hd = t.shape[-1]
    half = hd // 2
    inv_freq = jnp.power(ROPE_THETA, -2.0 * jnp.arange(half, dtype=jnp.float32) / hd)
    ang = positions.astype(jnp.float32)[:, :, None] * inv_freq
    cos = jnp.cos(ang)[:, :, None, :].astype(t.dtype)
    sin = jnp.sin(ang)[:, :, None, :].astype(t.dtype)
    t1, t2 = t[..., :half], t[..., half:]
    return jnp.concatenate([t1 * cos - t2 * sin, t2 * cos + t1 * sin], axis=-1)


def _short_conv(y, w):
    ch = y.shape[-1]
    return lax.conv_general_dilated(
        y, w[:, None, :].astype(y.dtype), window_strides=(1,),
        padding=((CONV_WIDTH - 1, 0),), dimension_numbers=('NWC', 'WIO', 'NWC'),
        feature_group_count=ch)


def _dilated_branch(q, k, v, window, dilation):
    bsz, seq, heads, hd = q.shape
    sub_len = seq // dilation
    span = window // dilation
    blk = span
    padded = -(-sub_len // blk) * blk
    nb = padded // blk
    n = bsz * dilation

    def to_sub(t):
        t = t.reshape(bsz, sub_len, dilation, heads, hd).transpose(0, 2, 1, 3, 4)
        t = t.reshape(n, sub_len, heads, hd)
        t = jnp.pad(t, ((0, 0), (0, padded - sub_len), (0, 0), (0, 0)))
        return t.reshape(n, nb, blk, heads, hd)

    def with_prev(t):
        prev = jnp.concatenate([jnp.zeros_like(t[:, :1]), t[:, :-1]], axis=1)
        return jnp.concatenate([prev, t], axis=2)

    qb = to_sub(q)
    kb = with_prev(to_sub(k))
    vb = with_prev(to_sub(v)).astype(jnp.float32)
    s = jnp.einsum('nbqhd,nbkhd->nbhqk', qb, kb).astype(jnp.float32) * (hd ** -0.5)
    qi = jnp.arange(blk)[:, None]
    kj = jnp.arange(2 * blk)[None, :]
    dist = qi + blk - kj
    band = (dist >= 0) & (dist <= span)
    has_prev = (jnp.arange(nb)[:, None, None] > 0) | (kj >= blk)[None]
    mask = band[None] & has_prev
    s = jnp.where(mask[None, :, None], s, -jnp.inf)
    m = jnp.max(s, axis=-1, keepdims=True)
    e = jnp.exp(s - m)
    den = jnp.sum(e, axis=-1)
    o = jnp.einsum('nbhqk,nbkhd->nbqhd', e, vb) / jnp.swapaxes(den, 2, 3)[..., None]
    lse = jnp.swapaxes(m[..., 0] + jnp.log(den), 2, 3)

    def from_sub(t):
        rest = t.shape[3:]
        t = t.reshape(n, padded, *rest)[:, :sub_len]
        t = t.reshape(bsz, dilation, sub_len, *rest)
        t = jnp.swapaxes(t, 1, 2)
        return t.reshape(bsz, seq, *rest)

    return from_sub(o), from_sub(lse)


def _dilated_attention(q, k, v):
    outs, lses = [], []
    for window, dilation in DILATED_PAIRS:
        o, l = _dilated_branch(q, k, v, window, dilation)
        outs.append(o)
        lses.append(l)
    wts = jax.nn.softmax(jnp.stack(lses), axis=0)
    return jnp.einsum('gbsh,gbshd->bshd', wts, jnp.stack(outs)).astype(q.dtype)


def _even_mixer(x, positions, w_in, conv_w, w_out):
    bsz, seq, _ = x.shape
    h = x @ w_in
    cuts = [CONV_CH, 2 * CONV_CH, 3 * CONV_CH, 3 * CONV_CH + ATT_WIDTH, 3 * CONV_CH + 2 * ATT_WIDTH]
    gate_b, gate_c, xa, q, k, v = jnp.split(h, cuts, axis=-1)
    y_conv = gate_b * _short_conv(gate_c * xa, conv_w)
    q = _rope(q.reshape(bsz, seq, ATT_HEADS, ATT_HEAD_DIM), positions)
    k = _rope(k.reshape(bsz, seq, ATT_HEADS, ATT_HEAD_DIM), positions)
    v = v.reshape(bsz, seq, ATT_HEADS, ATT_HEAD_DIM)
    y_att = _dilated_attention(q, k, v).reshape(bsz, seq, ATT_WIDTH)
    return jnp.concatenate([y_conv, y_att], axis=-1) @ w_out


def _mlstm_mixer(x, w_in, gate_bias, w_out):
    bsz, seq, _ = x.shape
    nh, dk, dv, cl = MLSTM_HEADS, MLSTM_QK_DIM, MLSTM_V_DIM, MLSTM_CHUNK
    nc = seq // cl
    h = x @ w_in
    cuts = [nh * dk, 2 * nh * dk, 2 * nh * dk + nh * dv, 2 * nh * dk + 2 * nh * dv,
            2 * nh * dk + 2 * nh * dv + nh]
    q, k, v, og, ig, fg = jnp.split(h, cuts, axis=-1)

    def chunked(t, d):
        return t.reshape(bsz, nc, cl, nh, d).transpose(0, 3, 1, 2, 4).astype(jnp.float32)

    def gate(t, b):
        t = t.astype(jnp.float32) + b.astype(jnp.float32)
        return t.reshape(bsz, nc, cl, nh).transpose(0, 3, 1, 2)

    q = chunked(q, dk)
    k = chunked(k, dk) * (dk ** -0.5)
    v = chunked(v, dv)
    i_pre = gate(ig, gate_bias[0])
    log_f = jax.nn.log_sigmoid(gate(fg, gate_bias[1]))
    bcum = jnp.cumsum(log_f, axis=-1)
    btot = bcum[..., -1]

    w_loc = btot[..., None] - bcum + i_pre
    m_loc = jnp.max(w_loc, axis=-1)
    a_loc = jnp.exp(w_loc - m_loc[..., None])
    c_loc = jnp.einsum('bhcs,bhcsv,bhcsk->bhcvk', a_loc, v, k)
    n_loc = jnp.einsum('bhcs,bhcsk->bhck', a_loc, k)

    def step(carry, xs):
        c, nvec, m = carry
        bt, ml, cloc, nloc = xs
        m_new = jnp.maximum(bt + m, ml)
        a_old = jnp.exp(bt + m - m_new)
        a_new = jnp.exp(ml - m_new)
        c_new = a_old[..., None, None] * c + a_new[..., None, None] * cloc
        n_new = a_old[..., None] * nvec + a_new[..., None] * nloc
        return (c_new, n_new, m_new), (c, nvec, m)

    init = (jnp.zeros((bsz, nh, dv, dk), jnp.float32),
            jnp.zeros((bsz, nh, dk), jnp.float32),
            jnp.zeros((bsz, nh), jnp.float32))
    xs = (jnp.moveaxis(btot, 2, 0), jnp.moveaxis(m_loc, 2, 0),
          jnp.moveaxis(c_loc, 2, 0), jnp.moveaxis(n_loc, 2, 0))
    _, (c_prev, n_prev, m_prev) = lax.scan(step, init, xs)
    c_prev = jnp.moveaxis(c_prev, 0, 2)
    n_prev = jnp.moveaxis(n_prev, 0, 2)
    m_prev = jnp.moveaxis(m_prev, 0, 2)

    causal = jnp.tril(jnp.ones((cl, cl), dtype=bool))
    dmat = bcum[..., :, None] - bcum[..., None, :] + i_pre[..., None, :]
    dmat = jnp.where(causal, dmat, -jnp.inf)
    g_inter = bcum + m_prev[..., None]
    m_t = jnp.maximum(g_inter, jnp.max(dmat, axis=-1))
    sc = jnp.einsum('bhctk,bhcsk->bhcts', q, k) * jnp.exp(dmat - m_t[..., None])
    a_inter = jnp.exp(g_inter - m_t)
    num = (a_inter[..., None] * jnp.einsum('bhcvk,bhctk->bhctv', c_prev, q)
           + jnp.einsum('bhcts,bhcsv->bhctv', sc, v))
    den = a_inter * jnp.einsum('bhck,bhctk->bhct', n_prev, q) + jnp.sum(sc, axis=-1)
    hh = num / jnp.maximum(jnp.abs(den), jnp.exp(-m_t))[..., None]
    hh = hh.transpose(0, 2, 3, 1, 4).reshape(bsz, seq, nh * dv).astype(x.dtype)
    return (jax.nn.sigmoid(og) * hh) @ w_out


def _peer(x, w_q, sub_keys, u, v):
    bsz, seq, dm = x.shape
    half = PEER_QDIM // 2
    kk = PEER_TOPK
    xb = x.reshape((bsz * seq) // PEER_TOKEN_BLOCK, PEER_TOKEN_BLOCK, dm)

    def block(xt):
        q = (xt @ w_q).reshape(xt.shape[0], PEER_HEADS, PEER_QDIM)
        s1 = jnp.einsum('thd,hnd->thn', q[..., :half], sub_keys[:, 0]).astype(jnp.float32)
        s2 = jnp.einsum('thd,hnd->thn', q[..., half:], sub_keys[:, 1]).astype(jnp.float32)
        v1, i1 = lax.top_k(s1, kk)
        v2, i2 = lax.top_k(s2, kk)
        cand = (v1[..., :, None] + v2[..., None, :]).reshape(xt.shape[0], PEER_HEADS, kk * kk)
        sc, ci = lax.top_k(cand, kk)
        e1 = jnp.take_along_axis(i1, ci // kk, axis=-1)
        e2 = jnp.take_along_axis(i2, ci % kk, axis=-1)
        idx = e1 * PEER_NKEYS + e2
        g = jax.nn.softmax(sc, axis=-1)
        hid = jax.nn.gelu(jnp.einsum('td,thkd->thk', xt, u[idx]).astype(jnp.float32), approximate=False)
        return jnp.einsum('thk,thkd->td', (g * hid).astype(xt.dtype), v[idx])

    return lax.map(block, xb).reshape(bsz, seq, dm)


def setup_inputs(seed: int = 0) -> dict:
    key = jax.random.key(seed)
    ks = jax.random.split(key, 17)

    def nrm(k, shape, scale):
        return jax.random.normal(k, shape, jnp.float32) * scale

    x = nrm(ks[0], (BATCH, SEQ, D_MODEL), 1.0)
    p = nrm(ks[1], (DEPTH, BATCH, SEQ, PLE_DIM), 1.0)
    positions = (jnp.arange(SEQ, dtype=jnp.int32)[None, :]
                 + jax.random.randint(ks[2], (BATCH, 1), 0, POS_OFFSET_MAX, dtype=jnp.int32))
    even_w_in = nrm(ks[3], (N_EVEN, D_MODEL, EVEN_IN), D_MODEL ** -0.5)
    even_conv_w = nrm(ks[4], (N_EVEN, CONV_WIDTH, CONV_CH), CONV_WIDTH ** -0.5)
    even_w_out = nrm(ks[5], (N_EVEN, CONV_CH + ATT_WIDTH, D_MODEL), (CONV_CH + ATT_WIDTH) ** -0.5 * BETA)
    odd_w_in = nrm(ks[6], (N_ODD, D_MODEL, ODD_IN), D_MODEL ** -0.5)
    odd_gate_bias = (nrm(ks[7], (N_ODD, 2, MLSTM_HEADS), 0.1)
                     + jnp.array([0.0, FORGET_BIAS_INIT], jnp.float32)[None, :, None])
    odd_w_out = nrm(ks[8], (N_ODD, MLSTM_HEADS * MLSTM_V_DIM, D_MODEL),
                    (MLSTM_HEADS * MLSTM_V_DIM) ** -0.5 * BETA)
    peer_w_q = nrm(ks[9], (DEPTH, D_MODEL, PEER_HEADS * PEER_QDIM), D_MODEL ** -0.5)
    peer_sub_keys = nrm(ks[10], (DEPTH, PEER_HEADS, 2, PEER_NKEYS, PEER_QDIM // 2), (PEER_QDIM // 2) ** -0.5)
    peer_u = nrm(ks[11], (DEPTH, PEER_EXPERTS, D_MODEL), D_MODEL ** -0.5)
    peer_v = nrm(ks[12], (DEPTH, PEER_EXPERTS, D_MODEL), BETA * PEER_HEADS ** -0.5)
    ple_w_proj = nrm(ks[13], (DEPTH, PLE_DIM, D_MODEL), PLE_DIM ** -0.5)
    ple_w_gate = nrm(ks[14], (DEPTH, D_MODEL, D_MODEL), D_MODEL ** -0.5)
    ln_gain = 1.0 + nrm(ks[15], (DEPTH, 2, D_MODEL), 0.02)
    ln_bias = nrm(ks[16], (DEPTH, 2, D_MODEL), 0.02)
    return {'x': x, 'p': p, 'positions': positions,
            'even_w_in': even_w_in, 'even_conv_w': even_conv_w, 'even_w_out': even_w_out,
            'odd_w_in': odd_w_in, 'odd_gate_bias': odd_gate_bias, 'odd_w_out': odd_w_out,
            'peer_w_q': peer_w_q, 'peer_sub_keys': peer_sub_keys, 'peer_u': peer_u, 'peer_v': peer_v,
            'ple_w_proj': ple_w_proj, 'ple_w_gate': ple_w_gate,
            'ln_gain': ln_gain, 'ln_bias': ln_bias}


def reference(x, p, positions, even_w_in, even_conv_w, even_w_out, odd_w_in, odd_gate_bias,
              odd_w_out, peer_w_q, peer_sub_keys, peer_u, peer_v, ple_w_proj, ple_w_gate,
              ln_gain, ln_bias):
    for layer in range(DEPTH):
        j = layer // 2
        if layer % 2 == 0:
            mix = _even_mixer(x, positions, even_w_in[j], even_conv_w[j], even_w_out[j])
        else:
            mix = _mlstm_mixer(x, odd_w_in[j], odd_gate_bias[j], odd_w_out[j])
        x = _layer_norm(ALPHA * x + mix, ln_gain[layer, 0], ln_bias[layer, 0])
        ffn = _peer(x, peer_w_q[layer], peer_sub_keys[layer], peer_u[layer], peer_v[layer])
        ple = jax.nn.sigmoid(x @ ple_w_gate[layer]) * (p[layer] @ ple_w_proj[layer])
        x = _layer_norm(ALPHA * x + ffn + ple, ln_gain[layer, 1], ln_bias[layer, 1])
    return x
```

```cpp
#include <hip/hip_runtime.h>
#include <cstdio>
#include <cstring>
#include <cstdint>
#include <cmath>
#define MK_ONE_LAUNCH 1
#define MK_FP8_INPROJ 1
namespace pg8 {
#define PG8_LAS __attribute__((address_space(3)))
typedef unsigned short bf16_t;
typedef short bf16x8 __attribute__((ext_vector_type(8)));
typedef float f32x4 __attribute__((ext_vector_type(4)));
typedef unsigned u32x4 __attribute__((ext_vector_type(4)));
constexpr int BM = 256, BK = 64, HALF = 128, HTB = HALF * BK * 2  , STAGE_BYTES = 8 * HTB, NXCD = 8, WGM = 8;

__host__ __device__ __forceinline__ int lds_byte(int r, int c) { const int st = (r >> 4) * 2 + (c >> 5), rr = r & 15, cc = c & 31, ob = rr * 64 + cc * 2; return st * 1024 + (ob ^ (((ob >> 9) & 1) << 5)); }
__host__ __device__ __forceinline__ void stage_rc(int b, int& R, int& C) { const int st = b / 1024, sb = b % 1024, swz = sb ^ (((sb >> 9) & 1) << 5); R = (st >> 1) * 16 + swz / 64; C = (st & 1) * 32 + (swz % 64) / 2; }
__host__ __device__ __forceinline__ int perm32(int rho) { const int n = rho >> 4, i = rho & 15; return 8 * (i >> 2) + 4 * n + (i & 3); }

struct Unit { int pm, pn; };
struct Gemm { const bf16_t* A; const bf16_t* Bt; int M, N, K; };

struct StaticOrder {
    int nM, nN, nwg, G, c;
    __host__ __device__ void init(int M, int N, int G_, int c_) { nM = M / BM; nN = N / BM; nwg = nM * nN; G = G_; c = c_; }
    __host__ __device__ bool next(int i, Unit& u) const {
        const long L = (long)i * G + c; if (L >= nwg) return false;
        int wgid = (int)L; { const int q = nwg / NXCD, r = nwg % NXCD, xcd = wgid % NXCD, off = wgid / NXCD; wgid = (xcd < r ? xcd * (q + 1) : r * (q + 1) + (xcd - r) * q) + off; }
        const int nig = WGM * nN, gid = wgid / nig, fm = gid * WGM, gsz = (nM - fm) < WGM ? (nM - fm) : WGM;
        u.pm = fm + ((wgid % nig) % gsz); u.pn = (wgid % nig) / gsz; return true;
    }
    __device__ __forceinline__ void a_ready(const Unit&) const {}
    __device__ __forceinline__ void done(const Unit&) const {}
};

__device__ __forceinline__ unsigned cvt_pk_bf16(float lo, float hi) { unsigned r; asm volatile("v_cvt_pk_bf16_f32 %0, %1, %2" : "=v"(r) : "v"(lo), "v"(hi)); return r; }
template <class Epi, class Sched, bool ALIGN_EPI = false, bool SP2 = false, bool FP8 = false>
__device__ __forceinline__ void gemm_phase(PG8_LAS unsigned char* lds, const Gemm g, const Sched& S, const Epi& E, const int tid_in) {
    const int tid = tid_in, wid = __builtin_amdgcn_readfirstlane(tid >> 6), lane = tid & 63, wr = wid >> 2, wc = wid & 3, fr = lane & 15, fq = lane >> 4;
    const int K = g.K, nt = K / BK;
    unsigned voffA[2], voffB[2];
#pragma unroll
    for (int i = 0; i < 2; ++i) { int R, C; stage_rc(tid * 16 + i * 8192, R, C); const int Rb = Epi::PERM ? ((R & ~31) + perm32(R & 31)) : R;
        voffA[i] = (unsigned)(R * K + C) * 2u; voffB[i] = (unsigned)(Rb * K + C) * 2u; }
    const size_t kstep = (size_t)(BK * 2);
    const size_t hstep = (size_t)HALF * K * 2;
    const size_t tstep = 2 * hstep;
    const unsigned ldsw = (unsigned)wid * 1024u;
    const int aoff = lds_byte(wr * 64 + fr, fq * 8), boff = lds_byte(wc * 32 + fr, fq * 8);
#define PG8_SA(b, h) (((b) * 2 + (h)) * HTB)
#define PG8_SB(b, h) ((4 + (b) * 2 + (h)) * HTB)
#define PG8_STAGE(bufoff, gbase, voff) do { _Pragma("unroll") for (int _i = 0; _i < 2; ++_i) { unsigned vo_ = (voff)[_i]; asm volatile("" : "+v"(vo_));   \
        __builtin_amdgcn_global_load_lds((const unsigned*)((const char*)(gbase) + vo_), (PG8_LAS unsigned*)(lds + (bufoff) + ldsw + _i * 8192), 16, 0, 0); } } while (0)
#define PG8_LDA(dst, b, h) do { _Pragma("unroll") for (int m = 0; m < 4; ++m) _Pragma("unroll") for (int k = 0; k < 2; ++k) dst[m][k] = *(const PG8_LAS bf16x8*)(lds + PG8_SA(b, h) + aoff + m * 2048 + k * 1024); } while (0)
#define PG8_LDB(dst, b, h) do { _Pragma("unroll") for (int n = 0; n < 2; ++n) _Pragma("unroll") for (int k = 0; k < 2; ++k) dst[n][k] = *(const PG8_LAS bf16x8*)(lds + PG8_SB(b, h) + boff + n * 2048 + k * 1024); } while (0)
#define PG8_MMA(ai, bj, At, Bt) do { __builtin_amdgcn_s_setprio(1); \
        if constexpr (FP8) {   \
            _Pragma("unroll") for (int m = 0; m < 4; ++m) _Pragma("unroll") for (int n = 0; n < 2; ++n) _Pragma("unroll") for (int k = 0; k < 2; ++k) \
                acc[ai][bj][m][n] = __builtin_bit_cast(f32x4, __builtin_amdgcn_mfma_i32_16x16x64_i8(__builtin_bit_cast(pg8_i4, Bt[n][k]), __builtin_bit_cast(pg8_i4, At[m][k]), __builtin_bit_cast(pg8_i4, acc[ai][bj][m][n]), 0, 0, 0)); \
        } else { \
        _Pragma("unroll") for (int m = 0; m < 4; ++m) _Pragma("unroll") for (int n = 0; n < 2; ++n) _Pragma("unroll") for (int k = 0; k < 2; ++k) \
        acc[ai][bj][m][n] = __builtin_amdgcn_mfma_f32_16x16x32_bf16(Bt[n][k], At[m][k], acc[ai][bj][m][n], 0, 0, 0); } __builtin_amdgcn_s_setprio(0); } while (0)
#define PG8_WAIT_V(n) asm volatile("s_waitcnt vmcnt(" #n ")" ::: "memory")
#define PG8_WAIT_L(n) asm volatile("s_waitcnt lgkmcnt(" #n ")" ::: "memory")
#define PG8_BAR __builtin_amdgcn_s_barrier()
#define PG8_SCHED __builtin_amdgcn_sched_barrier(0)
    Unit cur, nxt; int ui = 0;
    if (!S.next(0, cur)) return;
    f32x4 acc[2][2][4][2];
    { float z_ = 0.f; asm volatile("" : "+v"(z_));
#pragma unroll
    for (int a = 0; a < 2; ++a)
#pragma unroll
        for (int b = 0; b < 2; ++b)
#pragma unroll
            for (int m = 0; m < 4; ++m)
#pragma unroll
                for (int n = 0; n < 2; ++n) acc[a][b][m][n] = (f32x4){z_, z_, z_, z_}; }
    typedef int pg8_i4 __attribute__((ext_vector_type(4))); typedef long pg8_l2 __attribute__((ext_vector_type(2)));
    bf16x8 At[4][2], B0[2][2], B1[2][2];
    const char* cA = (const char*)g.A + (size_t)cur.pm * tstep; const char* cB = (const char*)g.Bt + (size_t)cur.pn * tstep;
    S.a_ready(cur);
    if constexpr (SP2) {
        PG8_STAGE(PG8_SB(0, 0), cB, voffB); PG8_STAGE(PG8_SB(0, 1), cB + hstep, voffB); PG8_STAGE(PG8_SA(0, 0), cA, voffA); PG8_STAGE(PG8_SA(0, 1), cA + hstep, voffA);
        if (wr == 1) PG8_BAR;
        PG8_WAIT_V(2); PG8_BAR;
        PG8_STAGE(PG8_SB(1, 0), cB + kstep, voffB); PG8_STAGE(PG8_SA(1, 0), cA + kstep, voffA); PG8_STAGE(PG8_SB(1, 1), cB + hstep + kstep, voffB);
        PG8_WAIT_V(6); PG8_BAR;
    } else {
        PG8_STAGE(PG8_SB(0, 0), cB, voffB); PG8_STAGE(PG8_SA(0, 0), cA, voffA); PG8_STAGE(PG8_SB(0, 1), cB + hstep, voffB); PG8_STAGE(PG8_SA(0, 1), cA + hstep, voffA);
        if (wr == 1) PG8_BAR;
        PG8_WAIT_V(4); PG8_BAR;
        PG8_STAGE(PG8_SB(1, 0), cB + kstep, voffB); PG8_STAGE(PG8_SA(1, 0), cA + kstep, voffA); PG8_STAGE(PG8_SB(1, 1), cB + hstep + kstep, voffB);
        PG8_WAIT_V(6); PG8_BAR;
    }
    for (;;) {
        const bool has_next = S.next(ui + 1, nxt);
        const char* nA = has_next ? (const char*)g.A + (size_t)nxt.pm * tstep : cA; const char* nB = has_next ? (const char*)g.Bt + (size_t)nxt.pn * tstep : cB;
        for (int t = 0; t < nt; t += 2) {
            const bool last = (t == nt - 2);
            const char* a1 = cA + (size_t)(t + 1) * kstep;
            const char* a2 = last ? nA : cA + (size_t)(t + 2) * kstep; const char* b2 = last ? nB : cB + (size_t)(t + 2) * kstep;
            const char* a3 = a2 + kstep; const char* b3 = b2 + kstep;
            if (last && has_next) S.a_ready(nxt);
            if constexpr (SP2) {
            PG8_LDB(B0, 0, 0); PG8_LDB(B1, 0, 1); PG8_SCHED; PG8_LDA(At, 0, 0); PG8_STAGE(PG8_SA(1, 1), a1 + hstep, voffA);
            PG8_WAIT_V(8); PG8_WAIT_L(0); PG8_BAR; PG8_MMA(0, 0, At, B0); PG8_MMA(0, 1, At, B1); PG8_BAR; PG8_SCHED;
            PG8_LDA(At, 0, 1); PG8_STAGE(PG8_SB(0, 0), b2, voffB); PG8_STAGE(PG8_SB(0, 1), b2 + hstep, voffB); PG8_STAGE(PG8_SA(0, 0), a2, voffA);
            PG8_WAIT_V(8); PG8_WAIT_L(0); PG8_BAR; PG8_MMA(1, 0, At, B0); PG8_MMA(1, 1, At, B1); PG8_BAR; PG8_SCHED;
            PG8_LDB(B0, 1, 0); PG8_LDB(B1, 1, 1); PG8_SCHED; PG8_LDA(At, 1, 0); PG8_STAGE(PG8_SA(0, 1), a2 + hstep, voffA);
            PG8_WAIT_V(8); PG8_WAIT_L(0); PG8_BAR; PG8_MMA(0, 0, At, B0); PG8_MMA(0, 1, At, B1); PG8_BAR; PG8_SCHED;
            PG8_LDA(At, 1, 1); PG8_STAGE(PG8_SB(1, 0), b3, voffB); PG8_STAGE(PG8_SB(1, 1), b3 + hstep, voffB); PG8_STAGE(PG8_SA(1, 0), a3, voffA);
            PG8_WAIT_V(8); PG8_WAIT_L(0); PG8_BAR; PG8_MMA(1, 0, At, B0); PG8_MMA(1, 1, At, B1); PG8_BAR; PG8_SCHED;
            } else {
            PG8_LDB(B0, 0, 0); PG8_SCHED; PG8_LDA(At, 0, 0); PG8_STAGE(PG8_SA(1, 1), a1 + hstep, voffA);
            PG8_WAIT_L(8); PG8_BAR; PG8_WAIT_L(0); PG8_MMA(0, 0, At, B0); PG8_BAR; PG8_SCHED;
            PG8_LDB(B1, 0, 1); PG8_STAGE(PG8_SB(0, 0), b2, voffB);
            PG8_BAR; PG8_WAIT_L(0); PG8_MMA(0, 1, At, B1); PG8_BAR;
            PG8_LDA(At, 0, 1); PG8_STAGE(PG8_SA(0, 0), a2, voffA);
            PG8_BAR; PG8_WAIT_L(0); PG8_MMA(1, 0, At, B0); PG8_BAR; PG8_SCHED;
            PG8_STAGE(PG8_SB(0, 1), b2 + hstep, voffB);
            PG8_WAIT_V(6); PG8_BAR; PG8_MMA(1, 1, At, B1); PG8_BAR;
            PG8_LDB(B0, 1, 0); PG8_SCHED; PG8_LDA(At, 1, 0); PG8_STAGE(PG8_SA(0, 1), a2 + hstep, voffA);
            PG8_WAIT_L(8); PG8_BAR; PG8_WAIT_L(0); PG8_MMA(0, 0, At, B0); PG8_BAR; PG8_SCHED;
            PG8_LDB(B1, 1, 1); PG8_STAGE(PG8_SB(1, 0), b3, voffB);
            PG8_BAR; PG8_WAIT_L(0); PG8_MMA(0, 1, At, B1); PG8_BAR;
            PG8_LDA(At, 1, 1); PG8_STAGE(PG8_SA(1, 0), a3, voffA);
            PG8_BAR; PG8_WAIT_L(0); PG8_MMA(1, 0, At, B0); PG8_BAR; PG8_SCHED;
            PG8_STAGE(PG8_SB(1, 1), b3 + hstep, voffB);
            PG8_WAIT_V(6); PG8_BAR; PG8_MMA(1, 1, At, B1); PG8_BAR;
            }
        }
        if constexpr (ALIGN_EPI) { if (wr == 0) PG8_BAR; }
        if constexpr (!Epi::AFTER_DRAIN) { E(acc, cur, wr, wc, fr, fq); S.done(cur); }
        if (!has_next) break;
        { float z_ = 0.f; asm volatile("" : "+v"(z_));
#pragma unroll
        for (int a = 0; a < 2; ++a)
#pragma unroll
            for (int b = 0; b < 2; ++b)
#pragma unroll
                for (int m = 0; m < 4; ++m)
#pragma unroll
                    for (int n = 0; n < 2; ++n) acc[a][b][m][n] = (f32x4){z_, z_, z_, z_}; }
        cur = nxt; cA = nA; cB = nB; ++ui;
        if constexpr (ALIGN_EPI) { if (wr == 1) PG8_BAR; }
    }
    PG8_WAIT_V(0);
    if constexpr (!ALIGN_EPI) { if (wr == 0) PG8_BAR; }
    PG8_BAR;
    if constexpr (Epi::AFTER_DRAIN) { E.fused(acc, cur, wr, wc, fr, fq, lds, wid, lane); S.done(cur); }
#undef PG8_SA
#undef PG8_SB
#undef PG8_STAGE
#undef PG8_LDA
#undef PG8_LDB
#undef PG8_MMA
#undef PG8_WAIT_V
#undef PG8_WAIT_L
#undef PG8_BAR
#undef PG8_SCHED
}
}
namespace mk {
#ifndef MK_FP8_INPROJ
#define MK_FP8_INPROJ 1
#endif
constexpr int D = 2048, NB = 2, S = 8192, T = NB * S, DEPTH = 4;
constexpr float ALPHA = 1.681792830507429f, LN_EPS = 1e-5f;
constexpr int NWAVES = 8, NTHREADS = 512;

#define GAS __attribute__((address_space(1)))
#define LAS __attribute__((address_space(3)))
typedef unsigned short bf16;
typedef unsigned v4u __attribute__((ext_vector_type(4)));
typedef unsigned v2u __attribute__((ext_vector_type(2)));
typedef float f32x4 __attribute__((ext_vector_type(4)));
typedef float f32x2 __attribute__((ext_vector_type(2)));
typedef short bf16x8 __attribute__((ext_vector_type(8)));
#define LDS_WAIT() asm volatile("s_waitcnt lgkmcnt(0)" ::: "memory")
#define VM_WAIT() asm volatile("s_waitcnt vmcnt(0)" ::: "memory")

constexpr size_t MiB = 1u << 20;
constexpr size_t WS_CTL = 0, CTL_ZERO_BYTES = 384 * 1024;
constexpr size_t WS_WIN = 1 * MiB;
constexpr size_t WS_WOUT = WS_WIN + 96 * MiB;
constexpr size_t WS_WQG = WS_WOUT + 32 * MiB;
constexpr size_t WS_WPJ = WS_WQG + 64 * MiB;
constexpr size_t WS_WGT = WS_WPJ + 4 * MiB;
constexpr size_t WS_WGB = WS_WGT + 512 * 1024;
constexpr size_t WS_UB = WS_WGT + 1 * MiB;
constexpr size_t WS_VB = WS_UB + 256 * MiB;
constexpr size_t WS_OG = WS_VB;
constexpr size_t WS_LSE = WS_VB + 96 * MiB;
constexpr size_t WS_CS = WS_VB + 104 * MiB;
constexpr size_t WS_SKB = WS_VB + 98 * MiB;
constexpr size_t WS_PB = WS_VB + 256 * MiB;
constexpr size_t WS_XF = WS_PB + 32 * MiB;
constexpr size_t WS_XB = WS_XF + 128 * MiB;
constexpr size_t WS_HB = WS_XB + 64 * MiB;
constexpr size_t WS_YB = WS_HB + 192 * MiB;
constexpr size_t WS_ZF = WS_YB + 64 * MiB;
constexpr size_t WS_X1F = WS_ZF + 128 * MiB;
constexpr size_t WS_PST = WS_X1F;
constexpr size_t WS_PC = WS_X1F + 4 * MiB;
constexpr size_t WS_X8 = WS_X1F + 16 * MiB;
constexpr size_t WS_SX = WS_X1F + 12 * MiB;
constexpr size_t WS_SW = WS_X1F + 13 * MiB;
constexpr size_t WS_Z8 = WS_X1F + 128 * MiB;
constexpr size_t WS_RS = WS_X1F + 14 * MiB;
constexpr size_t WS_SWQ = WS_X1F + 15 * MiB;
constexpr size_t WS_CMQ = 256 * 1024;
constexpr size_t WS_Y8 = WS_Z8 + 32 * MiB;
constexpr size_t WS_SY = WS_X1F + 14 * MiB + 512 * 1024;
constexpr size_t WS_SWO = WS_X1F + 15 * MiB + 512 * 1024;
constexpr size_t WS_CMO = 320 * 1024;
constexpr size_t WS_XQ = WS_X1F + 48 * MiB;
constexpr size_t WS_R4 = WS_X1F + 80 * MiB;
constexpr size_t WS_CM = 128 * 1024;
constexpr size_t WS_C12 = WS_X1F + 8 * MiB;
constexpr size_t WS_X1B = WS_X1F + 128 * MiB;
constexpr size_t WS_QB = WS_X1B + 64 * MiB;
constexpr size_t WS_PJ = WS_QB + 64 * MiB;
constexpr size_t WS_PLE = WS_PJ + 64 * MiB;
constexpr size_t WS_IDX = WS_PLE + 64 * MiB;
constexpr size_t WS_GW = WS_IDX + 8 * MiB;
constexpr size_t WS_CL = WS_GW + 8 * MiB;
constexpr size_t WS_ML = WS_CL + 128 * MiB;
constexpr size_t WS_GA = WS_ML + 2 * MiB;
constexpr size_t WS_END = WS_GA + 1 * MiB;
static_assert(WS_END <= (size_t)2040 * MiB, "workspace map");
constexpr int CW_BAR = 4096, CW_GSYNC = 16384;

constexpr int RING_OFF = 0, RING_BYTES = 143360;
constexpr int LDSCTL_OFF = RING_BYTES, MISC_OFF = LDSCTL_OFF + 320;
constexpr int STAT_OFF = 145408;
constexpr int LDS_BYTES = 145408 + 8192;

__device__ __forceinline__ unsigned f2bf(float f) { unsigned u = __builtin_bit_cast(unsigned, f); return (u + 0x7fffu + ((u >> 16) & 1u)) >> 16; }
__device__ __forceinline__ unsigned pk2(float lo, float hi) { return __builtin_amdgcn_perm(__builtin_bit_cast(unsigned, hi) + 0x8000u, __builtin_bit_cast(unsigned, lo) + 0x8000u, 0x07060302u); }
__device__ __forceinline__ float bflo(unsigned w) { return __builtin_bit_cast(float, w << 16); }
__device__ __forceinline__ float bfhi(unsigned w) { return __builtin_bit_cast(float, w & 0xffff0000u); }
__device__ __forceinline__ float bf2f(bf16 h) { return __builtin_bit_cast(float, (unsigned)h << 16); }
__device__ __forceinline__ int ov(int x) { asm volatile("" : "+v"(x)); return x; }
template <int CTRL> __device__ __forceinline__ unsigned dpp_u(unsigned v) { return (unsigned)__builtin_amdgcn_update_dpp((int)v, (int)v, CTRL, 0xF, 0xF, true); }
template <int M> __device__ __forceinline__ unsigned xlane_u(unsigned v, int lane) {
    if constexpr (M == 1) return dpp_u<0xB1>(v);
    else if constexpr (M == 2) return dpp_u<0x4E>(v);
    else if constexpr (M == 4) return dpp_u<0x1B>(dpp_u<0x141>(v));
    else if constexpr (M == 8) return dpp_u<0x128>(v);
    else if constexpr (M == 16) { auto r = __builtin_amdgcn_permlane16_swap(v, v, false, false); return (lane & 16) ? r[0] : r[1]; }
    else { auto r = __builtin_amdgcn_permlane32_swap(v, v, false, false); return (lane & 32) ? r[0] : r[1]; }
}
template <int M> __device__ __forceinline__ float xlane(float v, int lane) { return __uint_as_float(xlane_u<M>(__float_as_uint(v), lane)); }
__device__ __forceinline__ float xrow_sum(float v) {
    { auto r = __builtin_amdgcn_permlane16_swap(__float_as_uint(v), __float_as_uint(v), false, false); v = __uint_as_float(r[0]) + __uint_as_float(r[1]); }
    { auto r = __builtin_amdgcn_permlane32_swap(__float_as_uint(v), __float_as_uint(v), false, false); v = __uint_as_float(r[0]) + __uint_as_float(r[1]); }
    return v;
}
__device__ __forceinline__ float xrow_max(float v) {
    { auto r = __builtin_amdgcn_permlane16_swap(__float_as_uint(v), __float_as_uint(v), false, false); v = fmaxf(__uint_as_float(r[0]), __uint_as_float(r[1])); }
    { auto r = __builtin_amdgcn_permlane32_swap(__float_as_uint(v), __float_as_uint(v), false, false); v = fmaxf(__uint_as_float(r[0]), __uint_as_float(r[1])); }
    return v;
}
__device__ __forceinline__ int fresh_lane() { unsigned z = 0u; asm volatile("" : "+v"(z)); return (int)__builtin_amdgcn_mbcnt_hi(~0u, __builtin_amdgcn_mbcnt_lo(~0u, z)); }
__device__ __forceinline__ int shx_i(int v, int m, int lane) { return __builtin_amdgcn_ds_bpermute((lane ^ m) << 2, v); }
__device__ __forceinline__ float shx(float v, int m, int lane) { return __builtin_bit_cast(float, shx_i(__builtin_bit_cast(int, v), m, lane)); }
__device__ __forceinline__ int shl_i(int v, int from_lane) { return __builtin_amdgcn_ds_bpermute(from_lane << 2, v); }
__device__ __forceinline__ float wave_sum(float v) {
    const int l_ = fresh_lane();
#pragma unroll
    for (int o = 32; o >= 1; o >>= 1) v += shx(v, o, l_);
    return v;
}
__device__ __forceinline__ float wave_max(float v) {
    const int l_ = fresh_lane();
#pragma unroll
    for (int o = 32; o >= 1; o >>= 1) v = fmaxf(v, shx(v, o, l_));
    return v;
}
__device__ __forceinline__ float sigmoidf_(float x) { return 1.0f / (1.0f + __expf(-x)); }
__device__ __forceinline__ float logsig(float x) { return fminf(x, 0.f) - __logf(1.0f + __expf(-fabsf(x))); }
__device__ __forceinline__ float ln_rstd(float q) { return __builtin_amdgcn_rsqf((q + LN_EPS * (float)D) * (1.0f / D)); }

#define XB_TMO      128
#define XB_XCNT(j)  (256  + 64 * (j))
#define XB_XSUB(j)  (1280 + 64 * (j))
#define XB_XGEN(j)  (2304 + 64 * (j))
#define XB_TOP      3328
#define XB_TOPGEN   3392
#define XCD_BAR_WORDS 3456
#define XB_SPIN_CAP (1u << 22)

__device__ __forceinline__ unsigned xb_ld(unsigned* p)              { return __hip_atomic_load(p, __ATOMIC_RELAXED, __HIP_MEMORY_SCOPE_AGENT); }
__device__ __forceinline__ unsigned xb_add(unsigned* p, unsigned v) { return __hip_atomic_fetch_add(p, v, __ATOMIC_RELAXED, __HIP_MEMORY_SCOPE_AGENT); }
__device__ __forceinline__ unsigned xb_xcc_id() { return (unsigned)__builtin_amdgcn_s_getreg((3 << 11) | 20) & 0xFu; }
#define XB_SPIN(cond, bar) do { unsigned _sp = 0; while (cond) {   \
    if ((++_sp & 255u) == 0u) { if (xb_ld(&(bar)[XB_TMO])) break; if (_sp > XB_SPIN_CAP) { atomicAdd(&(bar)[XB_TMO], 1u); break; } } } } while (0)

struct XcdBarrier { unsigned* bar; unsigned x; volatile LAS unsigned* st; };

__device__ __forceinline__ XcdBarrier xcd_barrier_post(unsigned* bar, volatile LAS unsigned* st) {
    XcdBarrier b; b.bar = bar; b.x = xb_xcc_id(); b.st = st;
    if (threadIdx.x == 0) (void)xb_add(&bar[XB_XCNT(b.x)], 1u);
    return b;
}
__device__ __forceinline__ void xcd_barrier_complete(unsigned* bar, unsigned x, unsigned& nloc, unsigned& nx) {
    const unsigned G = gridDim.x * gridDim.y * gridDim.z;
    unsigned sum, cnt, mine, sp = 0u;
    for (;;) {
        sum = 0u; cnt = 0u; mine = 0u;
#pragma unroll 1
        for (unsigned j = 0; j < 16; ++j) { const unsigned c = xb_ld(&bar[XB_XCNT(j)]); sum += c; cnt += (c > 0u) ? 1u : 0u; mine = (j == x) ? c : mine; }
        if (sum == G) break;
        __builtin_amdgcn_s_sleep(1);
        if ((++sp & 255u) == 0u) { if (xb_ld(&bar[XB_TMO])) break; if (sp > XB_SPIN_CAP) { atomicAdd(&bar[XB_TMO], 1u); break; } }
    }
    nloc = mine > 0u ? mine : 1u; nx = cnt > 0u ? cnt : 1u;
}
__device__ __forceinline__ void xcd_barrier(const XcdBarrier& b, const bool leader) {
    asm volatile("s_waitcnt vmcnt(0)" ::: "memory");
    __syncthreads();
    if (leader) {
        unsigned* bar = b.bar; asm volatile("" : "+s"(bar));
        unsigned bx = b.x; asm volatile("" : "+s"(bx));
        __builtin_amdgcn_s_waitcnt(0);
        unsigned nloc = b.st[0], nx = b.st[1];
        if (nloc == 0u) { xcd_barrier_complete(bar, bx, nloc, nx); b.st[0] = nloc; b.st[1] = nx; }
        const unsigned old = xb_add(&bar[XB_XSUB(bx)], 1u);
        const unsigned gen = old / nloc;
        if (old + 1u == (gen + 1u) * nloc) {
            __builtin_amdgcn_fence(__ATOMIC_RELEASE, "agent");
            asm volatile("s_waitcnt vmcnt(0)" ::: "memory");
            const unsigned og = xb_add(&bar[XB_TOP], 1u);
            const unsigned tg = og / nx;
            if (og + 1u == (tg + 1u) * nx) xb_add(&bar[XB_TOPGEN], 1u);
            else XB_SPIN(xb_ld(&bar[XB_TOPGEN]) == tg, bar);
            __builtin_amdgcn_fence(__ATOMIC_ACQUIRE, "agent");
            xb_add(&bar[XB_XGEN(bx)], 1u);
            asm volatile("s_waitcnt vmcnt(0)" ::: "memory");
        } else {
            XB_SPIN(xb_ld(&bar[XB_XGEN(bx)]) == gen, bar);
            __builtin_amdgcn_fence(__ATOMIC_ACQUIRE, "agent");
            asm volatile("s_waitcnt vmcnt(0)" ::: "memory");
        }
    }
    __syncthreads();
}

struct EpiPlain {
    static constexpr bool PERM = true, AFTER_DRAIN = false;
    bf16* O; int ldc;
    __device__ __forceinline__ void operator()(const pg8::f32x4 (&acc)[2][2][4][2], const pg8::Unit& u, int wr, int wc, int fr_, int fq_) const {
        const int el_ = fresh_lane(), fr = el_ & 15, fq = el_ >> 4; (void)fr_; (void)fq_;
        const int row0 = u.pm * 256 + wr * 64 + fr, col0 = u.pn * 256 + wc * 32 + 8 * fq;
        const __amdgpu_buffer_rsrc_t rs = __builtin_amdgcn_make_buffer_rsrc((void*)O, (short)0, (int)((size_t)T * ldc * 2), 0x00020000);
#pragma unroll
        for (int ai = 0; ai < 2; ++ai)
#pragma unroll
            for (int m = 0; m < 4; ++m) { const unsigned ro = (unsigned)(((size_t)(row0 + ai * 128 + m * 16) * ldc + col0) * 2);
#pragma unroll
                for (int bj = 0; bj < 2; ++bj) { const pg8::f32x4 v0 = acc[ai][bj][m][0], v1 = acc[ai][bj][m][1];
                    v4u w; w.x = pg8::cvt_pk_bf16(v0[0], v0[1]); w.y = pg8::cvt_pk_bf16(v0[2], v0[3]); w.z = pg8::cvt_pk_bf16(v1[0], v1[1]); w.w = pg8::cvt_pk_bf16(v1[2], v1[3]);
                    __builtin_amdgcn_raw_buffer_store_b128(w, rs, ro + bj * 256, 0, 16); } }
    }
};
struct EpiPlainI8 {
    static constexpr bool PERM = true, AFTER_DRAIN = false;
    bf16* O; int ldc; const float* SX; const float* SW;
    __device__ __forceinline__ void operator()(const pg8::f32x4 (&acc)[2][2][4][2], const pg8::Unit& u, int wr, int wc, int fr_, int fq_) const {
        const int el_ = fresh_lane(), fr = el_ & 15, fq = el_ >> 4; (void)fr_; (void)fq_;
        const int row0 = u.pm * 256 + wr * 64 + fr, col0 = u.pn * 256 + wc * 32 + 8 * fq;
        const __amdgpu_buffer_rsrc_t rs = __builtin_amdgcn_make_buffer_rsrc((void*)O, (short)0, (int)((size_t)T * ldc * 2), 0x00020000);
        float sxv[8];
#pragma unroll
        for (int r8 = 0; r8 < 8; ++r8) sxv[r8] = SX[row0 + (r8 >> 2) * 128 + (r8 & 3) * 16];
#pragma unroll
        for (int bj = 0; bj < 2; ++bj) {
            const pg8::f32x4 s0 = *(const pg8::f32x4*)(SW + col0 + bj * 128), s1 = *(const pg8::f32x4*)(SW + col0 + bj * 128 + 4);
#pragma unroll
            for (int ai = 0; ai < 2; ++ai)
#pragma unroll
                for (int m = 0; m < 4; ++m) { const int row = row0 + ai * 128 + m * 16; const float sx = sxv[ai * 4 + m];
                    const unsigned ro = (unsigned)(((size_t)row * ldc + col0) * 2);
                    const pg8::f32x4 a0 = acc[ai][bj][m][0], a1 = acc[ai][bj][m][1];
                    typedef int i32x4_ __attribute__((ext_vector_type(4)));
                    const pg8::f32x4 f0 = __builtin_convertvector(__builtin_bit_cast(i32x4_, a0), pg8::f32x4) * (s0 * sx), f1 = __builtin_convertvector(__builtin_bit_cast(i32x4_, a1), pg8::f32x4) * (s1 * sx);
                    const float v[8] = {f0[0], f0[1], f0[2], f0[3], f1[0], f1[1], f1[2], f1[3]};
                    v4u w; w.x = pg8::cvt_pk_bf16(v[0], v[1]); w.y = pg8::cvt_pk_bf16(v[2], v[3]); w.z = pg8::cvt_pk_bf16(v[4], v[5]); w.w = pg8::cvt_pk_bf16(v[6], v[7]);
                    __builtin_amdgcn_raw_buffer_store_b128(w, rs, ro + bj * 256, 0, 16); }
        }
    }
};
struct EpiZ {
    static constexpr bool PERM = true, AFTER_DRAIN = false;
    bf16* Z; const float* XF; const bf16* XBh;
    float* PST;
    __device__ __forceinline__ void operator()(const pg8::f32x4 (&acc)[2][2][4][2], const pg8::Unit& u, int wr, int wc, int fr_, int fq_) const {
        const int el_ = fresh_lane(), fr = el_ & 15, fq = el_ >> 4; (void)fr_; (void)fq_;
        const int row0 = u.pm * 256 + wr * 64 + fr, col0 = u.pn * 256 + wc * 32 + 8 * fq;
#pragma unroll
        for (int ai = 0; ai < 2; ++ai)
#pragma unroll
            for (int m = 0; m < 4; ++m) { const size_t ro = (size_t)(row0 + ai * 128 + m * 16) * D + col0;
                float s = 0.f, ss = 0.f;
#pragma unroll
                for (int bj = 0; bj < 2; ++bj) {
                    pg8::f32x4 x0, x1;
                    if (XF) { x0 = *(const pg8::f32x4*)(XF + ro + bj * 128); x1 = *(const pg8::f32x4*)(XF + ro + bj * 128 + 4); }
                    else { const v4u xw = *(const v4u*)(XBh + ro + bj * 128); x0 = (pg8::f32x4){bflo(xw.x), bfhi(xw.x), bflo(xw.y), bfhi(xw.y)}; x1 = (pg8::f32x4){bflo(xw.z), bfhi(xw.z), bflo(xw.w), bfhi(xw.w)}; }
                    const pg8::f32x4 v0 = acc[ai][bj][m][0] + x0 * ALPHA, v1 = acc[ai][bj][m][1] + x1 * ALPHA;
                    s += ((v0[0] + v0[1]) + (v0[2] + v0[3])) + ((v1[0] + v1[1]) + (v1[2] + v1[3]));
                    ss += ((v0[0] * v0[0] + v0[1] * v0[1]) + (v0[2] * v0[2] + v0[3] * v0[3])) + ((v1[0] * v1[0] + v1[1] * v1[1]) + (v1[2] * v1[2] + v1[3] * v1[3]));
                    v4u w; w.x = pg8::cvt_pk_bf16(v0[0], v0[1]); w.y = pg8::cvt_pk_bf16(v0[2], v0[3]); w.z = pg8::cvt_pk_bf16(v1[0], v1[1]); w.w = pg8::cvt_pk_bf16(v1[2], v1[3]);
                    *(v4u*)(Z + ro + bj * 128) = w; asm volatile("" ::: "memory"); }
                s = xrow_sum(s); ss = xrow_sum(ss);
                if (fq == 0) *(f32x2*)(PST + ((size_t)(row0 + ai * 128 + m * 16) * 32 + u.pn * 4 + wc) * 2) = (f32x2){s, ss}; }
    }
};
struct EpiQG {
    static constexpr bool PERM = true, AFTER_DRAIN = false;
    bf16* QB; const bf16* PJ; bf16* PLE; const float* C12; LAS const float* ST; int pm0, pm1, pm2;
    __device__ __forceinline__ void operator()(const pg8::f32x4 (&acc)[2][2][4][2], const pg8::Unit& u, int wr, int wc, int fr_, int fq_) const {
        const int el_ = fresh_lane(), fr = el_ & 15, fq = el_ >> 4; (void)fr_; (void)fq_;
        const int row0 = u.pm * 256 + wr * 64 + fr;
        const int slot = (u.pm == pm0) ? 0 : (u.pm == pm1) ? 1 : (u.pm == pm2) ? 2 : 3;
        float rs_[8], mr_[8];
#pragma unroll
        for (int ai = 0; ai < 2; ++ai)
#pragma unroll
            for (int m = 0; m < 4; ++m) { const f32x2 st = *(LAS const f32x2*)(ST + (slot * 256 + wr * 64 + fr + ai * 128 + m * 16) * 2); rs_[ai * 4 + m] = st.x; mr_[ai * 4 + m] = st.y; }
        const bool isq = u.pn < 8;
        bf16* const OUTP = QB + (isq ? (size_t)0 : (size_t)((WS_PLE - WS_QB) / 2));
        const int col0 = (isq ? u.pn : u.pn - 8) * 256 + wc * 32 + 8 * fq, ncol = u.pn * 256 + wc * 32 + 8 * fq;
#pragma unroll
        for (int bj = 0; bj < 2; ++bj) {
            const pg8::f32x4* cp = (const pg8::f32x4*)(C12 + (size_t)(ncol + bj * 128) * 2);
            const pg8::f32x4 k0 = cp[0], k1 = cp[1], k2 = cp[2], k3 = cp[3];
#pragma unroll
            for (int ai = 0; ai < 2; ++ai)
#pragma unroll
                for (int m = 0; m < 4; ++m) { const size_t ro = (size_t)(row0 + ai * 128 + m * 16) * D + col0 + bj * 128;
                    const float rstd = rs_[ai * 4 + m], mr = mr_[ai * 4 + m];
                    pg8::f32x4 v0 = acc[ai][bj][m][0], v1 = acc[ai][bj][m][1];
                    v0[0] = v0[0] * rstd + (mr * k0[0] + k0[1]); v0[1] = v0[1] * rstd + (mr * k0[2] + k0[3]); v0[2] = v0[2] * rstd + (mr * k1[0] + k1[1]); v0[3] = v0[3] * rstd + (mr * k1[2] + k1[3]);
                    v1[0] = v1[0] * rstd + (mr * k2[0] + k2[1]); v1[1] = v1[1] * rstd + (mr * k2[2] + k2[3]); v1[2] = v1[2] * rstd + (mr * k3[0] + k3[1]); v1[3] = v1[3] * rstd + (mr * k3[2] + k3[3]);
                    if (!isq) { const v4u pj = *(const v4u*)(PJ + ro);
                        v0[0] = sigmoidf_(v0[0]) * bflo(pj.x); v0[1] = sigmoidf_(v0[1]) * bfhi(pj.x); v0[2] = sigmoidf_(v0[2]) * bflo(pj.y); v0[3] = sigmoidf_(v0[3]) * bfhi(pj.y);
                        v1[0] = sigmoidf_(v1[0]) * bflo(pj.z); v1[1] = sigmoidf_(v1[1]) * bfhi(pj.z); v1[2] = sigmoidf_(v1[2]) * bflo(pj.w); v1[3] = sigmoidf_(v1[3]) * bfhi(pj.w); }
                    v4u w; w.x = pg8::cvt_pk_bf16(v0[0], v0[1]); w.y = pg8::cvt_pk_bf16(v0[2], v0[3]); w.z = pg8::cvt_pk_bf16(v1[0], v1[1]); w.w = pg8::cvt_pk_bf16(v1[2], v1[3]);
                    *(v4u*)(OUTP + ro) = w; asm volatile("" ::: "memory"); }
        }
    }
};

struct EpiZ8 {
    static constexpr bool PERM = true, AFTER_DRAIN = false;
    bf16* Z; const float* XF; const bf16* XBh; const float* SY; const float* SWO;
    __device__ __forceinline__ void operator()(const pg8::f32x4 (&acc)[2][2][4][2], const pg8::Unit& u, int wr, int wc, int fr_, int fq_) const {
        typedef int i32x4_ __attribute__((ext_vector_type(4)));
        const int el_ = fresh_lane(), fr = el_ & 15, fq = el_ >> 4; (void)fr_; (void)fq_;
        const int row0 = u.pm * 256 + wr * 64 + fr, col0 = u.pn * 256 + wc * 32 + 8 * fq;
        float syv[8];
#pragma unroll
        for (int r8 = 0; r8 < 8; ++r8) syv[r8] = SY[row0 + (r8 >> 2) * 128 + (r8 & 3) * 16];
#pragma unroll
        for (int bj = 0; bj < 2; ++bj) {
            const pg8::f32x4 w0 = *(const pg8::f32x4*)(SWO + col0 + bj * 128), w1 = *(const pg8::f32x4*)(SWO + col0 + bj * 128 + 4);
#pragma unroll
            for (int ai = 0; ai < 2; ++ai)
#pragma unroll
                for (int m = 0; m < 4; ++m) { const int row = row0 + ai * 128 + m * 16; const size_t ro = (size_t)row * D + col0 + bj * 128; const float sy = syv[ai * 4 + m];
                    pg8::f32x4 x0, x1;
                    if (XF) { x0 = *(const pg8::f32x4*)(XF + ro); x1 = *(const pg8::f32x4*)(XF + ro + 4); }
                    else { const v4u xw = *(const v4u*)(XBh + ro); x0 = (pg8::f32x4){bflo(xw.x), bfhi(xw.x), bflo(xw.y), bfhi(xw.y)}; x1 = (pg8::f32x4){bflo(xw.z), bfhi(xw.z), bflo(xw.w), bfhi(xw.w)}; }
                    const pg8::f32x4 v0 = __builtin_convertvector(__builtin_bit_cast(i32x4_, acc[ai][bj][m][0]), pg8::f32x4) * (w0 * sy) + x0 * ALPHA;
                    const pg8::f32x4 v1 = __builtin_convertvector(__builtin_bit_cast(i32x4_, acc[ai][bj][m][1]), pg8::f32x4) * (w1 * sy) + x1 * ALPHA;
                    v4u w; w.x = pg8::cvt_pk_bf16(v0[0], v0[1]); w.y = pg8::cvt_pk_bf16(v0[2], v0[3]); w.z = pg8::cvt_pk_bf16(v1[0], v1[1]); w.w = pg8::cvt_pk_bf16(v1[2], v1[3]);
                    *(v4u*)(Z + ro) = w; asm volatile("" ::: "memory"); }
        }
    }
};
struct EpiQG8 {
    static constexpr bool PERM = true, AFTER_DRAIN = false;
    bf16* QB; const bf16* PJ; bf16* PLE; const float* C12; const float* RS; const float* SWQ;
    __device__ __forceinline__ void operator()(const pg8::f32x4 (&acc)[2][2][4][2], const pg8::Unit& u, int wr, int wc, int fr_, int fq_) const {
        typedef int i32x4_ __attribute__((ext_vector_type(4)));
        const int el_ = fresh_lane(), fr = el_ & 15, fq = el_ >> 4; (void)fr_; (void)fq_;
        const int row0 = u.pm * 256 + wr * 64 + fr;
        f32x2 rsv[8];
#pragma unroll
        for (int ai = 0; ai < 2; ++ai)
#pragma unroll
            for (int m = 0; m < 4; ++m) rsv[ai * 4 + m] = *(const f32x2*)(RS + (size_t)(row0 + ai * 128 + m * 16) * 2);
        const bool isq = u.pn < 8;
        bf16* const OUTP = QB + (isq ? (size_t)0 : (size_t)((WS_PLE - WS_QB) / 2));
        const int col0 = (isq ? u.pn : u.pn - 8) * 256 + wc * 32 + 8 * fq, ncol = u.pn * 256 + wc * 32 + 8 * fq;
#pragma unroll
        for (int bj = 0; bj < 2; ++bj) {
            const pg8::f32x4* cp = (const pg8::f32x4*)(C12 + (size_t)(ncol + bj * 128) * 2);
            const pg8::f32x4 k0 = cp[0], k1 = cp[1], k2 = cp[2], k3 = cp[3];
            const pg8::f32x4 w0 = *(const pg8::f32x4*)(SWQ + ncol + bj * 128), w1 = *(const pg8::f32x4*)(SWQ + ncol + bj * 128 + 4);
#pragma unroll
            for (int ai = 0; ai < 2; ++ai)
#pragma unroll
                for (int m = 0; m < 4; ++m) { const size_t ro = (size_t)(row0 + ai * 128 + m * 16) * D + col0 + bj * 128;
                    const float rz = rsv[ai * 4 + m].x, mr = rsv[ai * 4 + m].y;
                    pg8::f32x4 v0 = __builtin_convertvector(__builtin_bit_cast(i32x4_, acc[ai][bj][m][0]), pg8::f32x4) * (w0 * rz);
                    pg8::f32x4 v1 = __builtin_convertvector(__builtin_bit_cast(i32x4_, acc[ai][bj][m][1]), pg8::f32x4) * (w1 * rz);
                    v0[0] += mr * k0[0] + k0[1]; v0[1] += mr * k0[2] + k0[3]; v0[2] += mr * k1[0] + k1[1]; v0[3] += mr * k1[2] + k1[3];
                    v1[0] += mr * k2[0] + k2[1]; v1[1] += mr * k2[2] + k2[3]; v1[2] += mr * k3[0] + k3[1]; v1[3] += mr * k3[2] + k3[3];
                    if (!isq) { const v4u pj = *(const v4u*)(PJ + ro);
                        v0[0] = sigmoidf_(v0[0]) * bflo(pj.x); v0[1] = sigmoidf_(v0[1]) * bfhi(pj.x); v0[2] = sigmoidf_(v0[2]) * bflo(pj.y); v0[3] = sigmoidf_(v0[3]) * bfhi(pj.y);
                        v1[0] = sigmoidf_(v1[0]) * bflo(pj.z); v1[1] = sigmoidf_(v1[1]) * bfhi(pj.z); v1[2] = sigmoidf_(v1[2]) * bflo(pj.w); v1[3] = sigmoidf_(v1[3]) * bfhi(pj.w); }
                    v4u w; w.x = pg8::cvt_pk_bf16(v0[0], v0[1]); w.y = pg8::cvt_pk_bf16(v0[2], v0[3]); w.z = pg8::cvt_pk_bf16(v1[0], v1[1]); w.w = pg8::cvt_pk_bf16(v1[2], v1[3]);
                    *(v4u*)(OUTP + ro) = w; asm volatile("" ::: "memory"); }
        }
    }
};

struct Frame {
    LAS unsigned char* lds;
    int tid, lane, wave, gw, ngw, bid, nwg;
    const float *x, *p; const int* pos;
    const float *even_w_in, *even_conv_w, *even_w_out, *odd_w_in, *odd_gate_bias, *odd_w_out;
    const float *peer_w_q, *peer_sub_keys, *peer_u, *peer_v, *ple_w_proj, *ple_w_gate, *ln_gain, *ln_bias;
    float* out; unsigned char* ws;
};

__device__ __forceinline__ void ln1_row_stats(const Frame& F, const pg8::StaticOrder& So, int& pm0, int& pm1, int& pm2) {
    const float* PST = (const float*)(F.ws + WS_PST);
    LAS float* ST = (LAS float*)(F.lds + STAT_OFF);
    const int tid = F.wave * 64 + fresh_lane(), r = tid >> 1, h = tid & 1;
#pragma unroll
    for (int i = 0; i < 4; ++i) { pg8::Unit u; u.pm = -1; u.pn = 0;
        const bool have = So.next(i, u);
        if (i == 0) pm0 = have ? u.pm : -1; else if (i == 1) pm1 = have ? u.pm : -1; else if (i == 2) pm2 = have ? u.pm : -1;
        if (have) {
            const f32x4* pp = (const f32x4*)(PST + ((size_t)(u.pm * 256 + r) * 32 + h * 16) * 2);
            float s = 0.f, ss = 0.f;
#pragma unroll
            for (int q = 0; q < 8; ++q) { const f32x4 a = pp[q]; s += a[0] + a[2]; ss += a[1] + a[3]; }
            s += xlane<1>(s, 0); ss += xlane<1>(ss, 0);
            const float mean = s * (1.0f / D), var = fmaxf(ss * (1.0f / D) - mean * mean, 0.f), rstd = __builtin_amdgcn_rsqf(var + LN_EPS);
            if (h == 0) *(LAS f32x2*)(ST + (i * 256 + r) * 2) = (f32x2){rstd, -mean * rstd}; } }
    __syncthreads();
}

__device__ __forceinline__ void transpose_item(const float* W, int ldw, int K, bf16* WT, LAS float* scr, int kb, int nb, int lane) {
    const int k0 = 64 * kb, n0 = 32 * nb;
    const int n4 = (lane & 7) * 4, kr = lane >> 3;
#pragma unroll
    for (int i = 0; i < 8; ++i) { const int kk = 8 * i + kr; const f32x4 v = __builtin_nontemporal_load((const f32x4*)(W + (size_t)(k0 + kk) * ldw + n0 + n4));
        scr[kk * 33 + n4] = v[0]; scr[kk * 33 + n4 + 1] = v[1]; scr[kk * 33 + n4 + 2] = v[2]; scr[kk * 33 + n4 + 3] = v[3]; }
    LDS_WAIT();
    const int c = lane & 7;
#pragma unroll
    for (int j = 0; j < 4; ++j) { const int n = (lane >> 3) + 8 * j; const LAS float* s = scr + (8 * c) * 33 + n;
        v4u o; o.x = pk2(s[0 * 33], s[1 * 33]); o.y = pk2(s[2 * 33], s[3 * 33]); o.z = pk2(s[4 * 33], s[5 * 33]); o.w = pk2(s[6 * 33], s[7 * 33]);
        *(v4u*)(WT + (size_t)(n0 + n) * K + k0 + 8 * c) = o; }
    LDS_WAIT();
}
__device__ __forceinline__ void transpose_item_ln(const float* W, int ldw, int K, bf16* WT, LAS float* scr, int kb, int nb, int lane, const float* g, const float* b, float* PC, int ncol0) {
    const int k0 = 64 * kb, n0 = 32 * nb;
    const int n4 = (lane & 7) * 4, kr = lane >> 3;
#pragma unroll
    for (int i = 0; i < 8; ++i) { const int kk = 8 * i + kr; const f32x4 v = __builtin_nontemporal_load((const f32x4*)(W + (size_t)(k0 + kk) * ldw + n0 + n4));
        scr[kk * 33 + n4] = v[0]; scr[kk * 33 + n4 + 1] = v[1]; scr[kk * 33 + n4 + 2] = v[2]; scr[kk * 33 + n4 + 3] = v[3]; }
    LDS_WAIT();
    const int c = lane & 7;
    const f32x4 ga = *(const f32x4*)(g + k0 + 8 * c), gb = *(const f32x4*)(g + k0 + 8 * c + 4), ba = *(const f32x4*)(b + k0 + 8 * c), bb = *(const f32x4*)(b + k0 + 8 * c + 4);
#pragma unroll
    for (int j = 0; j < 4; ++j) { const int n = (lane >> 3) + 8 * j; const LAS float* s = scr + (8 * c) * 33 + n;
        const float w0 = s[0 * 33], w1 = s[1 * 33], w2 = s[2 * 33], w3 = s[3 * 33], w4 = s[4 * 33], w5 = s[5 * 33], w6 = s[6 * 33], w7 = s[7 * 33];
        v4u o; o.x = pk2(w0 * ga[0], w1 * ga[1]); o.y = pk2(w2 * ga[2], w3 * ga[3]); o.z = pk2(w4 * gb[0], w5 * gb[1]); o.w = pk2(w6 * gb[2], w7 * gb[3]);
        *(v4u*)(WT + (size_t)(n0 + n) * K + k0 + 8 * c) = o;
        float c1 = ((bflo(o.x) + bfhi(o.x)) + (bflo(o.y) + bfhi(o.y))) + ((bflo(o.z) + bfhi(o.z)) + (bflo(o.w) + bfhi(o.w)));
        float c2 = ((w0 * ba[0] + w1 * ba[1]) + (w2 * ba[2] + w3 * ba[3])) + ((w4 * bb[0] + w5 * bb[1]) + (w6 * bb[2] + w7 * bb[3]));
        c1 += xlane<1>(c1, 0); c2 += xlane<1>(c2, 0); c1 += xlane<2>(c1, 0); c2 += xlane<2>(c2, 0); c1 += xlane<4>(c1, 0); c2 += xlane<4>(c2, 0);
        if (c == 0) *(f32x2*)(PC + ((size_t)kb * 4096 + ncol0 + n0 + n) * 2) = (f32x2){c1, c2}; }
    LDS_WAIT();
}
__device__ __forceinline__ void transpose_mat_ln(const Frame& F, const float* W, bf16* WT, const float* g, const float* b, float* PC, int ncol0) {
    LAS float* scr = (LAS float*)(F.lds + RING_OFF + F.wave * 16384);
    for (int it = F.gw; it < 32 * 64; it += F.ngw) transpose_item_ln(W, 2048, 2048, WT, scr, it / 64, it % 64, F.lane, g, b, PC, ncol0);
}
__device__ __forceinline__ void colmax_item(const float* W, int ldw, unsigned* CM, int kb, int nb, int lane) {
    const int k0 = 64 * kb, n0 = 32 * nb, n4 = (lane & 7) * 4, kr = lane >> 3;
    float m[4] = {0.f, 0.f, 0.f, 0.f};
#pragma unroll
    for (int i = 0; i < 8; ++i) { const f32x4 v = *(const f32x4*)(W + (size_t)(k0 + 8 * i + kr) * ldw + n0 + n4);
        m[0] = fmaxf(m[0], fabsf(v[0])); m[1] = fmaxf(m[1], fabsf(v[1])); m[2] = fmaxf(m[2], fabsf(v[2])); m[3] = fmaxf(m[3], fabsf(v[3])); }
#pragma unroll
    for (int e = 0; e < 4; ++e) { m[e] = fmaxf(m[e], xlane<8>(m[e], 0)); m[e] = xrow_max(m[e]); }
    if (lane < 8) {
#pragma unroll
        for (int e = 0; e < 4; ++e) { const float me = m[e]; atomicMax(CM + n0 + n4 + e, __float_as_uint(me)); } }
}
__device__ __forceinline__ void colmax_mat(const Frame& F, const float* W, int ldw, unsigned* CM, int nblk = 192) {
    for (int it = F.gw; it < 32 * nblk; it += F.ngw) colmax_item(W, ldw, CM, it / nblk, it % nblk, F.lane);
}
__device__ __forceinline__ unsigned pk4_i8(float a, float b, float c, float d) {
    const int qa = (int)rintf(a), qb = (int)rintf(b), qc = (int)rintf(c), qd = (int)rintf(d);
    return (unsigned)(qa & 0xFF) | ((unsigned)(qb & 0xFF) << 8) | ((unsigned)(qc & 0xFF) << 16) | ((unsigned)qd << 24);
}
__device__ __forceinline__ void transpose_item_i8(const float* W, int ldw, int K, unsigned char* WT8, LAS float* scr, int kb, int nb, int lane, const unsigned* CM, float* SW) {
    const int k0 = 64 * kb, n0 = 32 * nb;
    const int n4 = (lane & 7) * 4, kr = lane >> 3;
    f32x4 inv;
#pragma unroll
    for (int e = 0; e < 4; ++e) { const float cm = __uint_as_float(__hip_atomic_load((unsigned*)CM + n0 + n4 + e, __ATOMIC_RELAXED, __HIP_MEMORY_SCOPE_AGENT)); inv[e] = (cm > 0.f) ? 127.0f / cm : 0.f; if (kb == 0 && kr == 0) SW[n0 + n4 + e] = cm * (1.0f / 127.0f); }
#pragma unroll
    for (int i = 0; i < 8; ++i) { const int kk = 8 * i + kr; const f32x4 v = __builtin_nontemporal_load((const f32x4*)(W + (size_t)(k0 + kk) * ldw + n0 + n4)) * inv;
        scr[kk * 33 + n4] = v[0]; scr[kk * 33 + n4 + 1] = v[1]; scr[kk * 33 + n4 + 2] = v[2]; scr[kk * 33 + n4 + 3] = v[3]; }
    LDS_WAIT();
    const int c = lane & 3;
#pragma unroll
    for (int j = 0; j < 2; ++j) { const int n = (lane >> 2) + 16 * j; const LAS float* sp = scr + (16 * c) * 33 + n;
        v4u o; o.x = pk4_i8(sp[0 * 33], sp[1 * 33], sp[2 * 33], sp[3 * 33]); o.y = pk4_i8(sp[4 * 33], sp[5 * 33], sp[6 * 33], sp[7 * 33]);
        o.z = pk4_i8(sp[8 * 33], sp[9 * 33], sp[10 * 33], sp[11 * 33]); o.w = pk4_i8(sp[12 * 33], sp[13 * 33], sp[14 * 33], sp[15 * 33]);
        *(v4u*)(WT8 + (size_t)(n0 + n) * K + k0 + 16 * c) = o; }
    LDS_WAIT();
}
__device__ __forceinline__ void transpose_mat_i8(const Frame& F, const float* W, int ldw, unsigned char* WT8, const unsigned* CM, float* SW, int nblk = 192) {
    LAS float* scr = (LAS float*)(F.lds + RING_OFF + F.wave * 17920);
    for (int it = F.gw; it < 32 * nblk; it += F.ngw) transpose_item_i8(W, ldw, 2048, WT8, scr, it / nblk, it % nblk, F.lane, CM, SW);
}
__device__ __forceinline__ void colmax_ln_item(const float* W, const float* g, unsigned* CM, int kb, int nb, int lane) {
    const int k0 = 64 * kb, n0 = 32 * nb, n4 = (lane & 7) * 4, kr = lane >> 3;
    float m[4] = {0.f, 0.f, 0.f, 0.f};
#pragma unroll
    for (int i = 0; i < 8; ++i) { const float gk = g[k0 + 8 * i + kr]; const f32x4 v = *(const f32x4*)(W + (size_t)(k0 + 8 * i + kr) * 2048 + n0 + n4);
        m[0] = fmaxf(m[0], fabsf(v[0] * gk)); m[1] = fmaxf(m[1], fabsf(v[1] * gk)); m[2] = fmaxf(m[2], fabsf(v[2] * gk)); m[3] = fmaxf(m[3], fabsf(v[3] * gk)); }
#pragma unroll
    for (int e = 0; e < 4; ++e) { m[e] = fmaxf(m[e], xlane<8>(m[e], 0)); m[e] = xrow_max(m[e]); }
    if (lane < 8) {
#pragma unroll
        for (int e = 0; e < 4; ++e) { const float me = m[e]; atomicMax(CM + n0 + n4 + e, __float_as_uint(me)); } }
}
__device__ __forceinline__ void colmax_ln_mat(const Frame& F, const float* W, const float* g, unsigned* CM) {
    for (int it = F.gw; it < 32 * 64; it += F.ngw) colmax_ln_item(W, g, CM, it / 64, it % 64, F.lane);
}
__device__ __forceinline__ void transpose_item_ln_i8(const float* W, unsigned char* WT8, LAS float* scr, int kb, int nb, int lane, const float* g, const float* b, float* PC, int ncol0, const unsigned* CM, float* SW) {
    const int k0 = 64 * kb, n0 = 32 * nb, K = 2048;
    const int n4 = (lane & 7) * 4, kr = lane >> 3;
    LAS float* scr2 = scr + 64 * 33;
    f32x4 inv;
#pragma unroll
    for (int e = 0; e < 4; ++e) { const float cm = __uint_as_float(__hip_atomic_load((unsigned*)CM + n0 + n4 + e, __ATOMIC_RELAXED, __HIP_MEMORY_SCOPE_AGENT)); inv[e] = (cm > 0.f) ? 127.0f / cm : 0.f; if (kb == 0 && kr == 0) SW[n0 + n4 + e] = cm * (1.0f / 127.0f); }
#pragma unroll
    for (int i = 0; i < 8; ++i) { const int kk = 8 * i + kr; const float gk = g[k0 + kk]; const f32x4 v = __builtin_nontemporal_load((const f32x4*)(W + (size_t)(k0 + kk) * 2048 + n0 + n4)); const f32x4 q = v * inv * gk;
        scr2[kk * 33 + n4] = v[0]; scr2[kk * 33 + n4 + 1] = v[1]; scr2[kk * 33 + n4 + 2] = v[2]; scr2[kk * 33 + n4 + 3] = v[3];
        scr[kk * 33 + n4] = q[0]; scr[kk * 33 + n4 + 1] = q[1]; scr[kk * 33 + n4 + 2] = q[2]; scr[kk * 33 + n4 + 3] = q[3]; }
    LDS_WAIT();
    const int c = lane & 3;
    float bk[16];
#pragma unroll
    for (int i = 0; i < 4; ++i) { const f32x4 bv = *(const f32x4*)(b + k0 + 16 * c + 4 * i); bk[4 * i] = bv[0]; bk[4 * i + 1] = bv[1]; bk[4 * i + 2] = bv[2]; bk[4 * i + 3] = bv[3]; }
#pragma unroll
    for (int j = 0; j < 2; ++j) { const int n = (lane >> 2) + 16 * j; const LAS float* sp = scr + (16 * c) * 33 + n; const LAS float* sr = scr2 + (16 * c) * 33 + n;
        float qv[16]; float sq = 0.f, c2 = 0.f;
#pragma unroll
        for (int i = 0; i < 16; ++i) { qv[i] = rintf(sp[i * 33]); sq += qv[i]; c2 += bk[i] * sr[i * 33]; }
        v4u o; o.x = pk4_i8(qv[0], qv[1], qv[2], qv[3]); o.y = pk4_i8(qv[4], qv[5], qv[6], qv[7]); o.z = pk4_i8(qv[8], qv[9], qv[10], qv[11]); o.w = pk4_i8(qv[12], qv[13], qv[14], qv[15]);
        *(v4u*)(WT8 + (size_t)(n0 + n) * K + k0 + 16 * c) = o;
        sq += xlane<1>(sq, 0); c2 += xlane<1>(c2, 0); sq += xlane<2>(sq, 0); c2 += xlane<2>(c2, 0);
        const float swn = __uint_as_float(__hip_atomic_load((unsigned*)CM + n0 + n, __ATOMIC_RELAXED, __HIP_MEMORY_SCOPE_AGENT)) * (1.0f / 127.0f);
        if (c == 0) *(f32x2*)(PC + ((size_t)kb * 4096 + ncol0 + n0 + n) * 2) = (f32x2){sq * swn, c2}; }
    LDS_WAIT();
}
__device__ __forceinline__ void transpose_mat_ln_i8(const Frame& F, const float* W, unsigned char* WT8, const float* g, const float* b, float* PC, int ncol0, const unsigned* CM, float* SW) {
    LAS float* scr = (LAS float*)(F.lds + RING_OFF + F.wave * 17920);
    for (int it = F.gw; it < 32 * 64; it += F.ngw) transpose_item_ln_i8(W, WT8, scr, it / 64, it % 64, F.lane, g, b, PC, ncol0, CM, SW);
}
__device__ __forceinline__ void quant_rows_i8(const Frame& F, const float* X, unsigned char* X8, float* SX, bf16* XBo) {
    const int lane = F.lane;
    for (int t = F.gw; t < T; t += F.ngw) {
        f32x4 v[8]; float am = 0.f;
#pragma unroll
        for (int i = 0; i < 8; ++i) { v[i] = __builtin_nontemporal_load((const f32x4*)(X + (size_t)t * D + 256 * i + lane * 4));
            am = fmaxf(am, fmaxf(fmaxf(fabsf(v[i][0]), fabsf(v[i][1])), fmaxf(fabsf(v[i][2]), fabsf(v[i][3])))); }
        am = wave_max(am);
        const float inv = (am > 0.f) ? 127.0f / am : 0.f;
        if (lane == 0) SX[t] = am * (1.0f / 127.0f);
#pragma unroll
        for (int i = 0; i < 8; ++i) { *(unsigned*)(X8 + (size_t)t * D + 256 * i + lane * 4) = pk4_i8(v[i][0] * inv, v[i][1] * inv, v[i][2] * inv, v[i][3] * inv);
            v2u o; o.x = pk2(v[i][0], v[i][1]); o.y = pk2(v[i][2], v[i][3]); *(v2u*)(XBo + (size_t)t * D + 256 * i + lane * 4) = o; }
    }
}
__device__ __forceinline__ void transpose_mat(const Frame& F, const float* W, int ldw, int K, int N, bf16* WT) {
    LAS float* scr = (LAS float*)(F.lds + RING_OFF + F.wave * 16384);
    const int nblk = N / 32, items = (K / 64) * nblk;
    for (int it = F.gw; it < items; it += F.ngw) transpose_item(W, ldw, K, WT, scr, it / nblk, it % nblk, F.lane);
}
__device__ __forceinline__ void convert_vec(const Frame& F, const float* src, bf16* dst, size_t n) {
    const size_t nv = n / 8, st = (size_t)F.ngw * 64;
    size_t i = (size_t)F.gw * 64 + F.lane;
    constexpr int U = 4;
    for (; i + (U - 1) * st < nv; i += U * st) {
        f32x4 a[U], b[U];
#pragma unroll
        for (int u = 0; u < U; ++u) { a[u] = __builtin_nontemporal_load((const f32x4*)(src + (i + u * st) * 8)); b[u] = __builtin_nontemporal_load((const f32x4*)(src + (i + u * st) * 8 + 4)); }
#pragma unroll
        for (int u = 0; u < U; ++u) { v4u o; o.x = pk2(a[u][0], a[u][1]); o.y = pk2(a[u][2], a[u][3]); o.z = pk2(b[u][0], b[u][1]); o.w = pk2(b[u][2], b[u][3]); *(v4u*)(dst + (i + u * st) * 8) = o; }
    }
    for (; i < nv; i += st) {
        const f32x4 a = __builtin_nontemporal_load((const f32x4*)(src + i * 8)), b = __builtin_nontemporal_load((const f32x4*)(src + i * 8 + 4));
        v4u o; o.x = pk2(a[0], a[1]); o.y = pk2(a[2], a[3]); o.z = pk2(b[0], b[1]); o.w = pk2(b[2], b[3]);
        *(v4u*)(dst + i * 8) = o;
    }
}
__device__ __forceinline__ float clamp448(float v) { return fminf(fmaxf(v, -448.0f), 448.0f); }
__device__ __forceinline__ unsigned pk4_fp8(const f32x4 a, float sc) {
    int w = 0;
    w = __builtin_amdgcn_cvt_pk_fp8_f32(clamp448(a[0] * sc), clamp448(a[1] * sc), w, false);
    w = __builtin_amdgcn_cvt_pk_fp8_f32(clamp448(a[2] * sc), clamp448(a[3] * sc), w, true);
    return (unsigned)w;
}
__device__ __forceinline__ void convert_fp8(const Frame& F, const float* src, unsigned char* dst, size_t n, float sc) {
    const size_t nv = n / 16;
    for (size_t i = (size_t)F.gw * 64 + F.lane; i < nv; i += (size_t)F.ngw * 64) {
        const f32x4 a = *(const f32x4*)(src + i * 16), b = *(const f32x4*)(src + i * 16 + 4), c = *(const f32x4*)(src + i * 16 + 8), d = *(const f32x4*)(src + i * 16 + 12);
        v4u o; o.x = pk4_fp8(a, sc); o.y = pk4_fp8(b, sc); o.z = pk4_fp8(c, sc); o.w = pk4_fp8(d, sc);
        *(v4u*)(dst + i * 16) = o;
    }
}
__device__ __forceinline__ unsigned pk8_fp4(const f32x4 a, const f32x4 b, float sc) {
    unsigned w = 0u;
    w = __builtin_amdgcn_cvt_scalef32_pk_fp4_f32(w, a[0] * sc, a[1] * sc, 1.0f, 0);
    w = __builtin_amdgcn_cvt_scalef32_pk_fp4_f32(w, a[2] * sc, a[3] * sc, 1.0f, 1);
    w = __builtin_amdgcn_cvt_scalef32_pk_fp4_f32(w, b[0] * sc, b[1] * sc, 1.0f, 2);
    w = __builtin_amdgcn_cvt_scalef32_pk_fp4_f32(w, b[2] * sc, b[3] * sc, 1.0f, 3);
    return w;
}
__device__ __forceinline__ unsigned pk8_int4(const f32x4 a, const f32x4 b, float sc, int off_even, int off_odd) {
    unsigned w = 0u;
#pragma unroll
    for (int i = 0; i < 4; ++i) { const int off = (i & 1) ? off_odd : off_even;
        const int qa = (int)fminf(fmaxf(rintf(a[i] * sc), -8.0f), 7.0f) + off, qb = (int)fminf(fmaxf(rintf(b[i] * sc), -8.0f), 7.0f) + off;
        w |= (unsigned)(qa & 15) << (4 * i); w |= (unsigned)(qb & 15) << (16 + 4 * i); }
    return w;
}
__device__ __forceinline__ void convert_int4(const Frame& F, const float* src, unsigned char* dst, size_t n, float sc, int off_even, int off_odd) {
    const size_t nv = n / 8, st = (size_t)F.ngw * 64;
    size_t i = (size_t)F.gw * 64 + F.lane;
    constexpr int U = 8;
    for (; i + (U - 1) * st < nv; i += U * st) {
        f32x4 a[U], b[U];
#pragma unroll
        for (int u = 0; u < U; ++u) { a[u] = __builtin_nontemporal_load((const f32x4*)(src + (i + u * st) * 8)); b[u] = __builtin_nontemporal_load((const f32x4*)(src + (i + u * st) * 8 + 4)); }
#pragma unroll
        for (int u = 0; u < U; ++u) *(unsigned*)(dst + (i + u * st) * 4) = pk8_int4(a[u], b[u], sc, off_even, off_odd);
    }
    for (; i < nv; i += st)
        *(unsigned*)(dst + i * 4) = pk8_int4(__builtin_nontemporal_load((const f32x4*)(src + i * 8)), __builtin_nontemporal_load((const f32x4*)(src + i * 8 + 4)), sc, off_even, off_odd);
}
__device__ __forceinline__ void convert_fp4(const Frame& F, const float* src, unsigned char* dst, size_t n, float sc) {
    const size_t nv = n / 8;
#pragma unroll 4
    for (size_t i = (size_t)F.gw * 64 + F.lane; i < nv; i += (size_t)F.ngw * 64)
        *(unsigned*)(dst + i * 4) = pk8_fp4(*(const f32x4*)(src + i * 8), *(const f32x4*)(src + i * 8 + 4), sc);
}
__device__ __forceinline__ void p0_prologue(const Frame& F) {
    unsigned char* ws = F.ws;
#if MK_FP8_INPROJ
    for (int l = 0; l < 4; ++l) { const float* g1 = F.ln_gain + (size_t)(l * 2) * D; unsigned* cmq = (unsigned*)(ws + WS_CMQ) + l * 4096;
        colmax_ln_mat(F, F.peer_w_q + (size_t)l * 2048 * 2048, g1, cmq); colmax_ln_mat(F, F.ple_w_gate + (size_t)l * 2048 * 2048, g1, cmq + 2048); }
    for (int l = 0; l < 4; ++l) { const int j = l >> 1;
        if (l & 1) colmax_mat(F, F.odd_w_in + (size_t)j * 2048 * 6160, 6160, (unsigned*)(ws + WS_CM) + l * 6144); else colmax_mat(F, F.even_w_in + (size_t)j * 2048 * 6144, 6144, (unsigned*)(ws + WS_CM) + l * 6144); }
#endif
    for (int l = 0; l < 4; ++l) {
        const int j = l >> 1;
        if ((l & 1) == 0) {
#if !MK_FP8_INPROJ
            transpose_mat(F, F.even_w_in + (size_t)j * 2048 * 6144, 6144, 2048, 6144, (bf16*)(ws + WS_WIN) + (size_t)l * 6144 * 2048);
#endif
#if MK_FP8_INPROJ
            colmax_mat(F, F.even_w_out + (size_t)j * 2048 * 2048, 2048, (unsigned*)(ws + WS_CMO) + l * 2048, 64);
#else
            transpose_mat(F, F.even_w_out + (size_t)j * 2048 * 2048, 2048, 2048, 2048, (bf16*)(ws + WS_WOUT) + (size_t)l * 2048 * 2048);
#endif
        } else {
#if !MK_FP8_INPROJ
            transpose_mat(F, F.odd_w_in + (size_t)j * 2048 * 6160, 6160, 2048, 6144, (bf16*)(ws + WS_WIN) + (size_t)l * 6144 * 2048);
#endif
#if MK_FP8_INPROJ
            colmax_mat(F, F.odd_w_out + (size_t)j * 2048 * 2048, 2048, (unsigned*)(ws + WS_CMO) + l * 2048, 64);
#else
            transpose_mat(F, F.odd_w_out + (size_t)j * 2048 * 2048, 2048, 2048, 2048, (bf16*)(ws + WS_WOUT) + (size_t)l * 2048 * 2048);
#endif
        }
#if !MK_FP8_INPROJ
        { const float* g1 = F.ln_gain + (size_t)(l * 2) * D; const float* b1 = F.ln_bias + (size_t)(l * 2) * D; float* pc = (float*)(ws + WS_PC) + (size_t)l * 32 * 4096 * 2;
          transpose_mat_ln(F, F.peer_w_q + (size_t)l * 2048 * 2048, (bf16*)(ws + WS_WQG) + (size_t)l * 4096 * 2048, g1, b1, pc, 0);
          transpose_mat_ln(F, F.ple_w_gate + (size_t)l * 2048 * 2048, (bf16*)(ws + WS_WQG) + (size_t)l * 4096 * 2048 + (size_t)2048 * 2048, g1, b1, pc, 2048); }
#endif
        transpose_mat(F, F.ple_w_proj + (size_t)l * 256 * 2048, 2048, 256, 2048, (bf16*)(ws + WS_WPJ) + (size_t)l * 2048 * 256);
    }
    { bf16* wgb = (bf16*)(ws + WS_WGB);
      for (int i = F.gw * 64 + F.lane; i < 2 * 16 * 2048; i += F.ngw * 64) { const int j = i / 32768, g = (i / 2048) % 16, k = i % 2048; wgb[i] = (bf16)f2bf(F.odd_w_in[(size_t)j * 2048 * 6160 + (size_t)k * 6160 + 6144 + g]); } }
    for (int l = 0; l < 4; ++l) {
        convert_int4(F, F.peer_u + (size_t)l * 16384 * 2048, ws + WS_UB + (size_t)l * (32u << 20), (size_t)16384 * 2048, 136.0f, 0, 0);
        convert_int4(F, F.peer_v + (size_t)l * 16384 * 2048, ws + WS_UB + (size_t)l * (32u << 20) + (16u << 20), (size_t)16384 * 2048, 20.0f, 8, 0);
    }
    convert_vec(F, F.p, (bf16*)(ws + WS_PB), (size_t)4 * T * 256);
    convert_vec(F, F.peer_sub_keys, (bf16*)(ws + WS_SKB), (size_t)4 * 8 * 2 * 128 * 128);
#if MK_FP8_INPROJ
    quant_rows_i8(F, F.x, ws + WS_X8, (float*)(ws + WS_SX), (bf16*)(ws + WS_XB));
#else
    convert_vec(F, F.x, (bf16*)(ws + WS_XB), (size_t)T * D);
#endif
    { float* cs = (float*)(ws + WS_CS);
      for (int i = F.gw * 64 + F.lane; i < T * 64; i += F.ngw * 64) { const int t = i >> 6, f = i & 63; const float ang = (float)F.pos[t] * powf(10000.0f, -2.0f * (float)f / 128.0f); float sn, cn; sincosf(ang, &sn, &cn); cs[(size_t)t * 128 + f] = cn; cs[(size_t)t * 128 + 64 + f] = sn; } }
}
#if MK_FP8_INPROJ
__device__ __forceinline__ void p0_prologue_b(const Frame& F) {
    unsigned char* ws = F.ws;
    for (int l = 0; l < 4; ++l) { const int j = l >> 1; const unsigned* cm = (const unsigned*)(ws + WS_CM) + l * 6144; float* sw = (float*)(ws + WS_SW) + l * 6144;
        if (l & 1) transpose_mat_i8(F, F.odd_w_in + (size_t)j * 2048 * 6160, 6160, ws + WS_WIN + (size_t)l * 6144 * 2048, cm, sw);
        else transpose_mat_i8(F, F.even_w_in + (size_t)j * 2048 * 6144, 6144, ws + WS_WIN + (size_t)l * 6144 * 2048, cm, sw); }
    for (int l = 0; l < 4; ++l) { const int j = l >> 1; const float* wo = ((l & 1) ? F.odd_w_out : F.even_w_out) + (size_t)j * 2048 * 2048;
        transpose_mat_i8(F, wo, 2048, ws + WS_WOUT + (size_t)l * 2048 * 2048, (const unsigned*)(ws + WS_CMO) + l * 2048, (float*)(ws + WS_SWO) + l * 2048, 64); }
    for (int l = 0; l < 4; ++l) { const float* g1 = F.ln_gain + (size_t)(l * 2) * D; const float* b1 = F.ln_bias + (size_t)(l * 2) * D; float* pc = (float*)(ws + WS_PC) + (size_t)l * 32 * 4096 * 2;
        const unsigned* cmq = (const unsigned*)(ws + WS_CMQ) + l * 4096; float* swq = (float*)(ws + WS_SWQ) + l * 4096; unsigned char* wt = ws + WS_WQG + (size_t)l * 4096 * 2048;
        transpose_mat_ln_i8(F, F.peer_w_q + (size_t)l * 2048 * 2048, wt, g1, b1, pc, 0, cmq, swq);
        transpose_mat_ln_i8(F, F.ple_w_gate + (size_t)l * 2048 * 2048, wt + (size_t)2048 * 2048, g1, b1, pc, 2048, cmq + 2048, swq + 2048); }
}
#endif
__device__ __forceinline__ void unpack8(const v4u w, float (&o)[8]) {
    o[0] = bflo(w.x); o[1] = bfhi(w.x); o[2] = bflo(w.y); o[3] = bfhi(w.y); o[4] = bflo(w.z); o[5] = bfhi(w.z); o[6] = bflo(w.w); o[7] = bfhi(w.w);
}
__device__ __forceinline__ v4u pack8(const float (&v)[8]) { v4u o; o.x = pk2(v[0], v[1]); o.y = pk2(v[2], v[3]); o.z = pk2(v[4], v[5]); o.w = pk2(v[6], v[7]); return o; }

__device__ __forceinline__ void ph_rope_conv(const Frame& F, int j) {
    bf16* HB = (bf16*)(F.ws + WS_HB); bf16* YB = (bf16*)(F.ws + WS_YB);
    const float* cw = F.even_conv_w + (size_t)j * 3 * 1024; const float* CS = (const float*)(F.ws + WS_CS);
    const int lane = fresh_lane();
    const int hd = lane >> 3, fc = lane & 7;
    for (int t = F.gw; t < T; t += F.ngw) {
        const int s = t % S;
        bf16* h0 = HB + (size_t)t * 6144;
        bf16* qp = h0 + 3072 + hd * 128 + 8 * fc; bf16* kp = h0 + 4096 + hd * 128 + 8 * fc;
        const v4u qa = *(const v4u*)qp, qb = *(const v4u*)(qp + 64), ka = *(const v4u*)kp, kb = *(const v4u*)(kp + 64);
        const f32x4 c0 = *(const f32x4*)(CS + (size_t)t * 128 + 8 * fc), c1 = *(const f32x4*)(CS + (size_t)t * 128 + 8 * fc + 4);
        const f32x4 s0 = *(const f32x4*)(CS + (size_t)t * 128 + 64 + 8 * fc), s1 = *(const f32x4*)(CS + (size_t)t * 128 + 64 + 8 * fc + 4);
#pragma unroll
        for (int half = 0; half < 2; ++half) {
            const int cc = lane * 16 + half * 8;
            float acc[8];
#pragma unroll
            for (int i = 0; i < 8; ++i) acc[i] = 0.f;
#pragma unroll
            for (int jj = 0; jj < 3; ++jj) {
                if (s - 2 + jj >= 0) {
                    const bf16* hr = h0 + (ptrdiff_t)(jj - 2) * 6144;
                    float gc[8], xa[8];
                    unpack8(*(const v4u*)(hr + 1024 + cc), gc); unpack8(*(const v4u*)(hr + 2048 + cc), xa);
                    const f32x4 w0 = *(const f32x4*)(cw + jj * 1024 + cc), w1 = *(const f32x4*)(cw + jj * 1024 + cc + 4);
#pragma unroll
                    for (int i = 0; i < 4; ++i) { acc[i] += w0[i] * gc[i] * xa[i]; acc[4 + i] += w1[i] * gc[4 + i] * xa[4 + i]; }
                }
            }
            float gb[8]; unpack8(*(const v4u*)(h0 + cc), gb);
#pragma unroll
            for (int i = 0; i < 8; ++i) acc[i] *= gb[i];
            *(v4u*)(YB + (size_t)t * 2048 + cc) = pack8(acc);
        }
        {
            float cs[8] = {c0[0], c0[1], c0[2], c0[3], c1[0], c1[1], c1[2], c1[3]}, sn[8] = {s0[0], s0[1], s0[2], s0[3], s1[0], s1[1], s1[2], s1[3]};
            float a[8], bq[8], oa[8], ob[8];
            unpack8(qa, a); unpack8(qb, bq);
#pragma unroll
            for (int i = 0; i < 8; ++i) { oa[i] = a[i] * cs[i] - bq[i] * sn[i]; ob[i] = bq[i] * cs[i] + a[i] * sn[i]; }
            *(v4u*)qp = pack8(oa); *(v4u*)(qp + 64) = pack8(ob);
            unpack8(ka, a); unpack8(kb, bq);
#pragma unroll
            for (int i = 0; i < 8; ++i) { oa[i] = a[i] * cs[i] - bq[i] * sn[i]; ob[i] = bq[i] * cs[i] + a[i] * sn[i]; }
            *(v4u*)kp = pack8(oa); *(v4u*)(kp + 64) = pack8(ob);
        }
    }
}

constexpr int AT_KROW = 272, AT_VROW = 528;
constexpr int AT_K_OFF = 0, AT_V_OFF = 256 * AT_KROW;
static_assert(AT_V_OFF + 128 * AT_VROW <= RING_BYTES, "attention LDS");
struct AttnItem { int hd, br, dsh, blk, tok0; };
__device__ __forceinline__ AttnItem attn_decode(int item) {
    AttnItem it; it.hd = item / 384; const int rest = item % 384; it.br = rest >> 7; const int idx = rest & 127;
    it.dsh = 2 * it.br; const int nb = 64 >> it.dsh, b = idx >> 6, r = (idx & 63) / nb; it.blk = (idx & 63) % nb; it.tok0 = b * S + r;
    return it;
}
__device__ __forceinline__ void attn_issue_q(const bf16* HB, const AttnItem& it, int tid, v4u (&qn)[4]) {
    const int wave_ = tid >> 6, l15_ = tid & 15, g_ = (tid & 63) >> 4; const int qtok_ = it.tok0 + ((it.blk * 128 + wave_ * 16 + l15_) << it.dsh);
#pragma unroll
    for (int st = 0; st < 4; ++st) qn[st] = *(const v4u*)(HB + (size_t)qtok_ * 6144 + 3072 + it.hd * 128 + 8 * g_ + 32 * st);
}
__device__ __forceinline__ bool attn_cont(const AttnItem& a, const AttnItem& p) { return a.hd == p.hd && a.br == p.br && a.tok0 == p.tok0 && a.blk == p.blk + 1; }
__device__ __forceinline__ void attn_issue(const bf16* HB, const AttnItem& it, int tid, v4u (&kreg)[8], v4u (&va)[4], v4u (&vb)[4], const bool cont) {
#pragma unroll
    for (int i = 0; i < 8; ++i) {
        if (cont && i < 4) continue;
        const int c = tid + 512 * i, kj = c >> 4, ch = c & 15;
        const int sub = (it.blk - 1) * 128 + kj;
        kreg[i] = (v4u){0u, 0u, 0u, 0u};
        if (sub >= 0) kreg[i] = *(const v4u*)(HB + (size_t)(it.tok0 + (sub << it.dsh)) * 6144 + 4096 + it.hd * 128 + ch * 8);
    }
#pragma unroll
    for (int i = 0; i < 4; ++i) {
        if (cont && i < 2) continue;
        const int u = tid + 512 * i;
        const int kp = ((u >> 8) << 4) | (u & 15), ch = (((u >> 6) & 3) << 2) | ((u >> 4) & 3);
        const int sub0 = (it.blk - 1) * 128 + 2 * kp;
        va[i] = (v4u){0u, 0u, 0u, 0u}; vb[i] = (v4u){0u, 0u, 0u, 0u};
        if (sub0 >= 0) { va[i] = *(const v4u*)(HB + (size_t)(it.tok0 + (sub0 << it.dsh)) * 6144 + 5120 + it.hd * 128 + ch * 8);
                         vb[i] = *(const v4u*)(HB + (size_t)(it.tok0 + ((sub0 + 1) << it.dsh)) * 6144 + 5120 + it.hd * 128 + ch * 8); }
    }
}
__device__ __forceinline__ void ph_attn_mfma(const Frame& F) {
    const bf16* HB = (const bf16*)(F.ws + WS_HB);
    bf16* OG = (bf16*)(F.ws + WS_OG); float* LSE = (float*)(F.ws + WS_LSE);
    LAS unsigned char* lds = F.lds;
    const int tid = (F.wave * 64 + fresh_lane()), lane = tid & 63, wave = F.wave;
    const int l15 = lane & 15, g = lane >> 4;
    const float sc2 = 0.08838834764831845f * 1.4426950408889634f;
    v4u kreg[8], va[4], vb[4], qn[4];
    const int vb0 = (F.nwg % 8 == 0) ? ((F.bid % 8) * (F.nwg / 8) + F.bid / 8) : F.bid;
    const int per = (3072 + F.nwg - 1) / F.nwg, ibase = vb0 * per, iend = (ibase + per < 3072) ? ibase + per : 3072;
    int px = 0; AttnItem itp = attn_decode(0); bool havep = false;
    if (ibase < iend) { const AttnItem it0 = attn_decode(ibase); attn_issue(HB, it0, tid, kreg, va, vb, false); attn_issue_q(HB, it0, tid, qn); }
    for (int item = ibase; item < iend; ++item) {
        const AttnItem it = attn_decode(item);
        const bool cont = havep && attn_cont(it, itp);
        px = cont ? (px ^ 1) : 0;
        itp = it; havep = true;
        const int hd = it.hd, br = it.br, dsh = it.dsh, blk = it.blk, tok0 = it.tok0;
        const int qtok = tok0 + ((blk * 128 + wave * 16 + l15) << dsh);
        v4u qf[4];
#pragma unroll
        for (int st = 0; st < 4; ++st) qf[st] = qn[st];
        __syncthreads();
#pragma unroll
        for (int i = 0; i < 8; ++i) { if (cont && i < 4) continue; const int c = tid + 512 * i, kj = (c >> 4) ^ (px << 7), ch = c & 15; *(LAS v4u*)(lds + AT_K_OFF + kj * AT_KROW + ch * 16) = kreg[i]; }
#pragma unroll
        for (int i = 0; i < 4; ++i) {
            if (cont && i < 2) continue;
            const int u = tid + 512 * i;
            const int kp = (((u >> 8) << 4) | (u & 15)) ^ (px << 6), ch = (((u >> 6) & 3) << 2) | ((u >> 4) & 3);
            const v4u a = va[i], bb = vb[i];
            LAS unsigned char* vbp = lds + AT_V_OFF + (ch * 8) * AT_VROW + kp * 4;
            *(LAS unsigned*)(vbp + 0 * AT_VROW) = (a.x & 0xffffu) | (bb.x << 16);      *(LAS unsigned*)(vbp + 1 * AT_VROW) = (a.x >> 16) | (bb.x & 0xffff0000u);
            *(LAS unsigned*)(vbp + 2 * AT_VROW) = (a.y & 0xffffu) | (bb.y << 16);      *(LAS unsigned*)(vbp + 3 * AT_VROW) = (a.y >> 16) | (bb.y & 0xffff0000u);
            *(LAS unsigned*)(vbp + 4 * AT_VROW) = (a.z & 0xffffu) | (bb.z << 16);      *(LAS unsigned*)(vbp + 5 * AT_VROW) = (a.z >> 16) | (bb.z & 0xffff0000u);
            *(LAS unsigned*)(vbp + 6 * AT_VROW) = (a.w & 0xffffu) | (bb.w << 16);      *(LAS unsigned*)(vbp + 7 * AT_VROW) = (a.w >> 16) | (bb.w & 0xffff0000u);
        }
        __syncthreads();
        if (item + 1 < iend) { const AttnItem itn = attn_decode(item + 1); attn_issue(HB, itn, tid, kreg, va, vb, attn_cont(itn, it)); }
        f32x4 sacc[9];
#pragma unroll
        for (int kt = 0; kt < 9; ++kt) {
            sacc[kt] = (f32x4){0.f, 0.f, 0.f, 0.f};
            const LAS unsigned char* kr = lds + AT_K_OFF + ((16 * (wave + kt) + l15) ^ (px << 7)) * AT_KROW + 16 * g;
#pragma unroll
            for (int st = 0; st < 4; ++st) {
                const bf16x8 af = *(const LAS bf16x8*)(kr + 64 * st);
                sacc[kt] = __builtin_amdgcn_mfma_f32_16x16x32_bf16(af, __builtin_bit_cast(bf16x8, qf[st]), sacc[kt], 0, 0, 0);
            }
        }
        float mx = -INFINITY;
#pragma unroll
        for (int kt = 0; kt < 9; ++kt)
#pragma unroll
            for (int i = 0; i < 4; ++i) {
                const int rel = 16 * kt + 4 * g + i - l15;
                const bool ok = (rel >= 0) && (rel <= 128) && (blk > 0 || (16 * (wave + kt) + 4 * g + i) >= 128);
                const float v = ok ? sacc[kt][i] * sc2 : -INFINITY;
                sacc[kt][i] = v; mx = fmaxf(mx, v);
            }
        mx = xrow_max(mx);
        float sum = 0.f;
#pragma unroll
        for (int kt = 0; kt < 9; ++kt)
#pragma unroll
            for (int i = 0; i < 4; ++i) { const float p = __builtin_amdgcn_exp2f(sacc[kt][i] - mx); sacc[kt][i] = p; sum += p; }
        sum = xrow_sum(sum);
        v4u pf[5];
#pragma unroll
        for (int m = 0; m < 5; ++m) {
            pf[m].x = pk2(sacc[2 * m][0], sacc[2 * m][1]); pf[m].y = pk2(sacc[2 * m][2], sacc[2 * m][3]);
            if (m < 4) { pf[m].z = pk2(sacc[2 * m + 1][0], sacc[2 * m + 1][1]); pf[m].w = pk2(sacc[2 * m + 1][2], sacc[2 * m + 1][3]); } else { pf[m].z = 0u; pf[m].w = 0u; }
        }
        const float rs = 1.0f / sum;
        bf16* orow = OG + ((size_t)br * T + qtok) * 1024 + hd * 128 + 4 * g;
#pragma unroll
        for (int dt = 0; dt < 8; ++dt) {
            f32x4 o = (f32x4){0.f, 0.f, 0.f, 0.f};
            const LAS unsigned char* vr = lds + AT_V_OFF + (16 * dt + l15) * AT_VROW;  const int kv0 = 16 * wave + 4 * g;
#pragma unroll
            for (int m = 0; m < 5; ++m) {
                const v2u p0 = *(const LAS v2u*)(vr + ((kv0 + 32 * m) ^ (px << 7)) * 2);
                const v2u p1 = *(const LAS v2u*)(vr + ((kv0 + 32 * m + (m < 4 ? 16 : 0)) ^ (px << 7)) * 2);
                const v4u af = (v4u){p0.x, p0.y, p1.x, p1.y};
                o = __builtin_amdgcn_mfma_f32_16x16x32_bf16(__builtin_bit_cast(bf16x8, af), __builtin_bit_cast(bf16x8, pf[m]), o, 0, 0, 0);
            }
            v2u w; w.x = pk2(o[0] * rs, o[1] * rs); w.y = pk2(o[2] * rs, o[3] * rs);
            *(v2u*)(orow + 16 * dt) = w;
        }
        if (g == 0) LSE[((size_t)br * T + qtok) * 8 + hd] = mx * 0.6931471805599453f + __logf(sum);
        if (item + 1 < iend) { const AttnItem itn = attn_decode(item + 1); attn_issue_q(HB, itn, tid, qn); }
    }
}
__device__ __forceinline__ void ph_attn_combine(const Frame& F) {
    const bf16* OG = (const bf16*)(F.ws + WS_OG); const float* LSE = (const float*)(F.ws + WS_LSE); bf16* YB = (bf16*)(F.ws + WS_YB);
    const int lane = fresh_lane(), hd = lane >> 3;
    for (int tb = F.gw; tb < T; tb += 2 * F.ngw) {
        v4u og[2][3][2]; float ls[2][3];
#if MK_FP8_INPROJ
        v4u cv[2][2];
#endif
#pragma unroll
        for (int r = 0; r < 2; ++r) { const int t = (tb + r * F.ngw < T) ? tb + r * F.ngw : tb;
#if MK_FP8_INPROJ
            cv[r][0] = *(const v4u*)(YB + (size_t)t * 2048 + lane * 16); cv[r][1] = *(const v4u*)(YB + (size_t)t * 2048 + lane * 16 + 8);
#endif
#pragma unroll
            for (int gq = 0; gq < 3; ++gq) { ls[r][gq] = LSE[((size_t)gq * T + t) * 8 + hd];
                og[r][gq][0] = *(const v4u*)(OG + ((size_t)gq * T + t) * 1024 + lane * 16); og[r][gq][1] = *(const v4u*)(OG + ((size_t)gq * T + t) * 1024 + lane * 16 + 8); } }
#pragma unroll
        for (int r = 0; r < 2; ++r) {
            const int t = tb + r * F.ngw;
            const float m = fmaxf(ls[r][0], fmaxf(ls[r][1], ls[r][2]));
            float w0 = __expf(ls[r][0] - m), w1 = __expf(ls[r][1] - m), w2 = __expf(ls[r][2] - m);
            const float inv = 1.0f / (w0 + w1 + w2); w0 *= inv; w1 *= inv; w2 *= inv;
#if MK_FP8_INPROJ
            float ya[16], yc[16]; float am = 0.f;
#pragma unroll
            for (int hh = 0; hh < 2; ++hh) {
                float a[8], bq[8], c[8], cc[8];
                unpack8(og[r][0][hh], a); unpack8(og[r][1][hh], bq); unpack8(og[r][2][hh], c); unpack8(cv[r][hh], cc);
#pragma unroll
                for (int i = 0; i < 8; ++i) { ya[hh * 8 + i] = w0 * a[i] + w1 * bq[i] + w2 * c[i]; yc[hh * 8 + i] = cc[i]; am = fmaxf(am, fmaxf(fabsf(ya[hh * 8 + i]), fabsf(cc[i]))); }
            }
            am = wave_max(am);
            const float qi = (am > 0.f) ? 127.0f / am : 0.f;
            if (t < T) {
                if (lane == 0) ((float*)(F.ws + WS_SY))[t] = am * (1.0f / 127.0f);
                v4u oc, oa;
                oc.x = pk4_i8(yc[0] * qi, yc[1] * qi, yc[2] * qi, yc[3] * qi); oc.y = pk4_i8(yc[4] * qi, yc[5] * qi, yc[6] * qi, yc[7] * qi); oc.z = pk4_i8(yc[8] * qi, yc[9] * qi, yc[10] * qi, yc[11] * qi); oc.w = pk4_i8(yc[12] * qi, yc[13] * qi, yc[14] * qi, yc[15] * qi);
                oa.x = pk4_i8(ya[0] * qi, ya[1] * qi, ya[2] * qi, ya[3] * qi); oa.y = pk4_i8(ya[4] * qi, ya[5] * qi, ya[6] * qi, ya[7] * qi); oa.z = pk4_i8(ya[8] * qi, ya[9] * qi, ya[10] * qi, ya[11] * qi); oa.w = pk4_i8(ya[12] * qi, ya[13] * qi, ya[14] * qi, ya[15] * qi);
                *(v4u*)(F.ws + WS_Y8 + (size_t)t * 2048 + lane * 16) = oc; *(v4u*)(F.ws + WS_Y8 + (size_t)t * 2048 + 1024 + lane * 16) = oa;
            }
#else
            if (t < T) {
#pragma unroll
                for (int hh = 0; hh < 2; ++hh) {
                    float a[8], bq[8], c[8], y[8];
                    unpack8(og[r][0][hh], a); unpack8(og[r][1][hh], bq); unpack8(og[r][2][hh], c);
#pragma unroll
                    for (int i = 0; i < 8; ++i) y[i] = w0 * a[i] + w1 * bq[i] + w2 * c[i];
                    *(v4u*)(YB + (size_t)t * 2048 + 1024 + lane * 16 + hh * 8) = pack8(y);
                }
            }
#endif
        }
    }
}
__device__ __forceinline__ void ph_quant_y(const Frame& F) {
    const bf16* Y = (const bf16*)(F.ws + WS_YB); unsigned char* Y8 = F.ws + WS_Y8; float* SY = (float*)(F.ws + WS_SY);
    const int lane = fresh_lane();
    for (int tb = F.gw; tb < T; tb += 4 * F.ngw) {
        v4u zr[4][4];
#pragma unroll
        for (int r = 0; r < 4; ++r) { const int t = tb + r * F.ngw;
#pragma unroll
            for (int jj = 0; jj < 4; ++jj) zr[r][jj] = (t < T) ? *(const v4u*)(Y + (size_t)t * D + jj * 512 + lane * 8) : (v4u){0u, 0u, 0u, 0u}; }
#pragma unroll
        for (int r = 0; r < 4; ++r) {
            const int t = tb + r * F.ngw;
            float v[32]; float am = 0.f;
#pragma unroll
            for (int jj = 0; jj < 4; ++jj) { float u8[8]; unpack8(zr[r][jj], u8);
#pragma unroll
                for (int i = 0; i < 8; ++i) { v[jj * 8 + i] = u8[i]; am = fmaxf(am, fabsf(u8[i])); } }
            am = wave_max(am);
            const float inv = (am > 0.f) ? 127.0f / am : 0.f;
            if (t < T) {
                if (lane == 0) SY[t] = am * (1.0f / 127.0f);
#pragma unroll
                for (int jj = 0; jj < 4; ++jj) { v2u o; o.x = pk4_i8(v[jj * 8] * inv, v[jj * 8 + 1] * inv, v[jj * 8 + 2] * inv, v[jj * 8 + 3] * inv); o.y = pk4_i8(v[jj * 8 + 4] * inv, v[jj * 8 + 5] * inv, v[jj * 8 + 6] * inv, v[jj * 8 + 7] * inv);
                    *(v2u*)(Y8 + (size_t)t * D + jj * 512 + lane * 8) = o; }
            }
        }
    }
}

__device__ __forceinline__ void ph_c12(const Frame& F, int layer) {
    const float* pc = (const float*)(F.ws + WS_PC) + (size_t)layer * 32 * 4096 * 2; float* c12 = (float*)(F.ws + WS_C12) + (size_t)layer * 4096 * 2;
    for (int n = F.gw * 64 + fresh_lane(); n < 4096; n += F.ngw * 64) { float c1 = 0.f, c2 = 0.f;
#pragma unroll 8
        for (int kb = 0; kb < 32; ++kb) { const f32x2 v = *(const f32x2*)(pc + ((size_t)kb * 4096 + n) * 2); c1 += v.x; c2 += v.y; }
        *(f32x2*)(c12 + (size_t)n * 2) = (f32x2){c1, c2}; }
}

constexpr int TK_ROW = 272;
constexpr int TK_SK_OFF = 0, TK_IX_OFF = 256 * TK_ROW;
static_assert(TK_IX_OFF + 8 * 2048 <= RING_BYTES, "topk LDS");
__device__ __forceinline__ void ce_desc(float& a, float& b) { const float mx = __builtin_fmaxf(a, b), mn = __builtin_fminf(a, b); a = mx; b = mn; }
__device__ __forceinline__ void sort16_desc(float (&a)[16]) {
#pragma unroll
    for (int k = 2; k <= 16; k <<= 1)
#pragma unroll
        for (int j = k >> 1; j > 0; j >>= 1)
#pragma unroll
            for (int i = 0; i < 16; ++i) { const int l = i ^ j; if (l > i) { if ((i & k) == 0 || k == 16) ce_desc(a[i], a[l]); else ce_desc(a[l], a[i]); } }
}
__device__ __forceinline__ void bitonic_merge16_desc(float (&a)[16]) {
#pragma unroll
    for (int j = 8; j > 0; j >>= 1)
#pragma unroll
        for (int i = 0; i < 16; ++i) { const int l = i ^ j; if (l > i) ce_desc(a[i], a[l]); }
}
__device__ __forceinline__ void sort8_desc(float (&a)[8]) {
#pragma unroll
    for (int k = 2; k <= 8; k <<= 1)
#pragma unroll
        for (int j = k >> 1; j > 0; j >>= 1)
#pragma unroll
            for (int i = 0; i < 8; ++i) { const int l = i ^ j; if (l > i) { if ((i & k) == 0 || k == 8) ce_desc(a[i], a[l]); else ce_desc(a[l], a[i]); } }
}
__device__ __forceinline__ void xlane_merge16(float (&a)[16], int xm, int lane) {
    float b[16];
#pragma unroll
    for (int i = 0; i < 16; ++i) b[i] = shx(a[15 - i], xm, lane);
#pragma unroll
    for (int i = 0; i < 16; ++i) a[i] = __builtin_fmaxf(a[i], b[i]);
    bitonic_merge16_desc(a);
}
__device__ __forceinline__ float packlow(float x, unsigned code, unsigned mask) { return __builtin_bit_cast(float, (__builtin_bit_cast(unsigned, x) & ~mask) | code); }
__device__ __forceinline__ float sel4(int g, float x0, float x1, float x2, float x3) { return (g == 0) ? x0 : ((g == 1) ? x1 : ((g == 2) ? x2 : x3)); }

__device__ __forceinline__ void ph_topk(const Frame& F, int layer) {
    const bf16* QB = (const bf16*)(F.ws + WS_QB); int* IDX = (int*)(F.ws + WS_IDX); float* GWt = (float*)(F.ws + WS_GW);
    const bf16* SKB = (const bf16*)(F.ws + WS_SKB) + (size_t)layer * 8 * 2 * 128 * 128;
    LAS unsigned char* lds = F.lds;
    const int tid = (F.wave * 64 + fresh_lane()), lane = tid & 63, wave = F.wave, l15 = lane & 15, g = lane >> 4;
    LAS int* ixl = (LAS int*)(lds + TK_IX_OFF + wave * 2048 + l15 * 128);
    const float NEG = -3.0e38f;
    int h_staged = -1;
    v4u qfa[2][4];
    if (F.bid < 1024) { const int hd0 = F.bid & 7, t0q = (F.bid >> 3) * 128 + wave * 16 + l15;
#pragma unroll
        for (int p = 0; p < 2; ++p)
#pragma unroll
            for (int st = 0; st < 4; ++st) qfa[p][st] = *(const v4u*)(QB + (size_t)t0q * 2048 + hd0 * 256 + p * 128 + 8 * g + 32 * st); }
    for (int item = F.bid; item < 1024; item += F.nwg) {
        const int hd = item & 7, tb = item >> 3;
        if (hd != h_staged) {
            __syncthreads();
#pragma unroll
            for (int i = 0; i < 8; ++i) { const int c = tid + 512 * i, row = c >> 4, ch = c & 15;
                *(LAS v4u*)(lds + TK_SK_OFF + row * TK_ROW + ch * 16) = *(const v4u*)(SKB + ((size_t)hd * 256 + row) * 128 + ch * 8); }
            __syncthreads();
            h_staged = hd;
        }
        const int t = tb * 128 + wave * 16 + l15;
        float v1[16], v2[16];
#pragma unroll
        for (int p = 0; p < 2; ++p) {
            const v4u (&qf)[4] = qfa[p];
            float lo[16], hi[16];
#pragma unroll
            for (int kt = 0; kt < 8; ++kt) {
                f32x4 acc = (f32x4){0.f, 0.f, 0.f, 0.f};
                const LAS unsigned char* kr = lds + TK_SK_OFF + (p * 128 + 16 * kt + l15) * TK_ROW + 16 * g;
#pragma unroll
                for (int st = 0; st < 4; ++st) acc = __builtin_amdgcn_mfma_f32_16x16x32_bf16(*(const LAS bf16x8*)(kr + 64 * st), __builtin_bit_cast(bf16x8, qf[st]), acc, 0, 0, 0);
#pragma unroll
                for (int i = 0; i < 4; ++i) { const float pv = packlow(acc[i], (unsigned)(16 * kt + 4 * g + i), 0x7Fu); if (kt < 4) lo[4 * kt + i] = pv; else hi[4 * (kt - 4) + i] = pv; }
            }
            sort16_desc(lo); sort16_desc(hi);
#pragma unroll
            for (int i = 0; i < 16; ++i) lo[i] = __builtin_fmaxf(lo[i], hi[15 - i]);
            bitonic_merge16_desc(lo);
            xlane_merge16(lo, 16, lane); xlane_merge16(lo, 32, lane);
#pragma unroll
            for (int i = 0; i < 16; ++i) { if (p == 0) v1[i] = lo[i]; else v2[i] = lo[i]; }
        }
        if (item + F.nwg < 1024) { const int itn = item + F.nwg, hdn = itn & 7, tn = (itn >> 3) * 128 + wave * 16 + l15;
#pragma unroll
            for (int p = 0; p < 2; ++p)
#pragma unroll
                for (int st = 0; st < 4; ++st) qfa[p][st] = *(const v4u*)(QB + (size_t)tn * 2048 + hdn * 256 + p * 128 + 8 * g + 32 * st); }
        if (g == 0) {
#pragma unroll
            for (int i = 0; i < 16; ++i) { ixl[i] = (int)(__builtin_bit_cast(unsigned, v1[i]) & 0x7Fu); ixl[16 + i] = (int)(__builtin_bit_cast(unsigned, v2[i]) & 0x7Fu); }
        }
        float c[16], e[8];
        {
            const float s0 = sel4(g, v1[0], v1[1], v1[2], v1[3]), s1 = sel4(g, v1[4], v1[5], v1[6], v1[7]);
            const float s2 = sel4(g, v1[8], v1[9], v1[10], v1[11]), s3 = sel4(g, v1[12], v1[13], v1[14], v1[15]);
            const int n0 = (g == 0) ? 16 : ((g == 1) ? 8 : ((g == 2) ? 5 : 4));
#pragma unroll
            for (int bq = 0; bq < 16; ++bq) c[bq] = (bq < n0) ? packlow(s0 + v2[bq], (unsigned)((g << 4) | bq), 0xFFu) : NEG;
            e[0] = packlow(s1 + v2[0], (unsigned)(((4 + g) << 4) | 0), 0xFFu);
            e[1] = packlow(s1 + v2[1], (unsigned)(((4 + g) << 4) | 1), 0xFFu);
            e[2] = (g == 0) ? packlow(s1 + v2[2], (unsigned)((4 << 4) | 2), 0xFFu) : NEG;
            e[3] = packlow(s2 + v2[0], (unsigned)(((8 + g) << 4) | 0), 0xFFu);
            e[4] = packlow(s3 + v2[0], (unsigned)(((12 + g) << 4) | 0), 0xFFu);
            e[5] = NEG; e[6] = NEG; e[7] = NEG;
        }
        sort8_desc(e);
#pragma unroll
        for (int i = 8; i < 16; ++i) c[i] = __builtin_fmaxf(c[i], e[15 - i]);
        bitonic_merge16_desc(c);
        xlane_merge16(c, 16, lane); xlane_merge16(c, 32, lane);
        float r[4], ex[4], esum = 0.f;
#pragma unroll
        for (int i = 0; i < 4; ++i) { r[i] = sel4(g, c[i], c[4 + i], c[8 + i], c[12 + i]); ex[i] = __expf(r[i] - c[0]); esum += ex[i]; }
        esum = xrow_sum(esum);
        const float rinv = 1.0f / esum;
        LDS_WAIT();
        int ido[4]; float go[4];
#pragma unroll
        for (int i = 0; i < 4; ++i) { const unsigned code = __builtin_bit_cast(unsigned, r[i]) & 0xFFu; ido[i] = ixl[code >> 4] * 128 + ixl[16 + (code & 15u)]; go[i] = ex[i] * rinv; }
        *(int4*)(IDX + (size_t)t * 128 + hd * 16 + 4 * g) = make_int4(ido[0], ido[1], ido[2], ido[3]);
        *(f32x4*)(GWt + (size_t)t * 128 + hd * 16 + 4 * g) = (f32x4){go[0], go[1], go[2], go[3]};
        LDS_WAIT();
    }
}

__device__ __forceinline__ float rdlane_f(float v, int l) { return __builtin_bit_cast(float, __builtin_amdgcn_readlane(__builtin_bit_cast(int, v), l)); }
constexpr float U4_SCALE = 136.0f, V4_SCALE = 20.0f;
constexpr unsigned ROW4 = 1024u, TAB4 = 16384u * 1024u;
__device__ __forceinline__ f32x2 dot8_fp4(const unsigned w, const f32x2* x, f32x2 a) {
    a += __builtin_amdgcn_cvt_scalef32_pk_f32_fp4(w, 1.0f, 0) * x[0]; a += __builtin_amdgcn_cvt_scalef32_pk_f32_fp4(w, 1.0f, 1) * x[1];
    a += __builtin_amdgcn_cvt_scalef32_pk_f32_fp4(w, 1.0f, 2) * x[2]; a += __builtin_amdgcn_cvt_scalef32_pk_f32_fp4(w, 1.0f, 3) * x[3];
    return a;
}
__device__ __forceinline__ void axpy8_fp4(const unsigned w, const float wt, f32x2* acc) {
    const f32x2 w2 = {wt, wt};
    acc[0] += __builtin_amdgcn_cvt_scalef32_pk_f32_fp4(w, 1.0f, 0) * w2; acc[1] += __builtin_amdgcn_cvt_scalef32_pk_f32_fp4(w, 1.0f, 1) * w2;
    acc[2] += __builtin_amdgcn_cvt_scalef32_pk_f32_fp4(w, 1.0f, 2) * w2; acc[3] += __builtin_amdgcn_cvt_scalef32_pk_f32_fp4(w, 1.0f, 3) * w2;
}
__device__ __forceinline__ void gather_sorted_ids(const int* IDX, const float* GWt, int t, int lane, int& id0, int& id1, float& g0, float& g1) {
    const int ia = IDX[(size_t)t * 128 + lane], ib = IDX[(size_t)t * 128 + 64 + lane];
    const float ga = GWt[(size_t)t * 128 + lane], gb = GWt[(size_t)t * 128 + 64 + lane];
    unsigned a = ((unsigned)ia << 16) | (unsigned)fminf(ga * 65536.0f, 65535.0f), b = ((unsigned)ib << 16) | (unsigned)fminf(gb * 65536.0f, 65535.0f);
#pragma unroll
    for (int k = 2; k <= 128; k <<= 1) {
        if (k == 128) { const unsigned mn = a < b ? a : b, mx = a < b ? b : a; a = mn; b = mx; }
#pragma unroll
        for (int j = (k >= 128 ? 32 : k >> 1); j > 0; j >>= 1) {
            const bool lower = (lane & j) == 0;
            const bool upa = (k >= 128) ? true : ((lane & k) == 0);
            const bool upb = (k >= 128) ? true : (k == 64 ? false : ((lane & k) == 0));
            const unsigned oa = (unsigned)shx_i((int)a, j, lane), ob = (unsigned)shx_i((int)b, j, lane);
            a = (lower == upa) ? (a < oa ? a : oa) : (a < oa ? oa : a);
            b = (lower == upb) ? (b < ob ? b : ob) : (b < ob ? ob : b);
        }
    }
    id0 = (int)(a >> 16); id1 = (int)(b >> 16);
    g0 = ((float)(a & 0xffffu) + 0.5f) * (1.0f / 65536.0f); g1 = ((float)(b & 0xffffu) + 0.5f) * (1.0f / 65536.0f);
}
__device__ __forceinline__ float gelu_as(float v) {
    const float av = fabsf(v), t = __builtin_amdgcn_rcpf(av * 0.2316418882f + 1.0f);
    float q = t * 0.5307027145f + (-0.7265760135f); q = q * t + 0.7107068705f; q = q * t + (-0.142248368f); q = q * t + 0.127414796f; q = q * t;
    const float m = v * (q * __builtin_amdgcn_exp2f((v * v) * (-0.72134752044f)));
    return v < 0.f ? m : v - m;
}
__device__ __forceinline__ void ph_quant_z(const Frame& F, int layer) {
    const bf16* Z = (const bf16*)(F.ws + WS_ZF); unsigned char* Z8 = F.ws + WS_Z8; float* RS = (float*)(F.ws + WS_RS);
    unsigned* XQ = (unsigned*)(F.ws + WS_XQ); float* R4 = (float*)(F.ws + WS_R4);
    const float* gain1 = F.ln_gain + (size_t)(layer * 2) * D; const float* bias1 = F.ln_bias + (size_t)(layer * 2) * D;
    const int lane = fresh_lane();
    for (int tb = F.gw; tb < T; tb += 4 * F.ngw) {
        v4u zr[4][4];
#pragma unroll
        for (int r = 0; r < 4; ++r) { const int t = tb + r * F.ngw;
#pragma unroll
            for (int jj = 0; jj < 4; ++jj) zr[r][jj] = (t < T) ? *(const v4u*)(Z + (size_t)t * D + jj * 512 + lane * 8) : (v4u){0u, 0u, 0u, 0u}; }
#pragma unroll
        for (int r = 0; r < 4; ++r) {
            const int t = tb + r * F.ngw;
            float v[32]; float s = 0.f, am = 0.f;
#pragma unroll
            for (int jj = 0; jj < 4; ++jj) { float u8[8]; unpack8(zr[r][jj], u8);
#pragma unroll
                for (int i = 0; i < 8; ++i) { v[jj * 8 + i] = u8[i]; s += u8[i]; am = fmaxf(am, fabsf(u8[i])); } }
            const float mean = wave_sum(s) * (1.0f / D); float q = 0.f;
#pragma unroll
            for (int i = 0; i < 32; ++i) { const float d = v[i] - mean; q += d * d; }
            const float rstd = ln_rstd(wave_sum(q));
            am = wave_max(am);
            const float inv = (am > 0.f) ? 127.0f / am : 0.f;
            if (t < T) {
                if (lane == 0) *(f32x2*)(RS + (size_t)t * 2) = (f32x2){rstd * am * (1.0f / 127.0f), -mean * rstd};
#pragma unroll
                for (int jj = 0; jj < 4; ++jj) { v2u o; o.x = pk4_i8(v[jj * 8] * inv, v[jj * 8 + 1] * inv, v[jj * 8 + 2] * inv, v[jj * 8 + 3] * inv); o.y = pk4_i8(v[jj * 8 + 4] * inv, v[jj * 8 + 5] * inv, v[jj * 8 + 6] * inv, v[jj * 8 + 7] * inv);
                    *(v2u*)(Z8 + (size_t)t * D + jj * 512 + lane * 8) = o; }
            }
            float ax = 0.f;
#pragma unroll
            for (int jj = 0; jj < 4; ++jj) { const int c = jj * 512 + lane * 8;
                const f32x4 g0 = *(const f32x4*)(gain1 + c), g1 = *(const f32x4*)(gain1 + c + 4), b0 = *(const f32x4*)(bias1 + c), b1 = *(const f32x4*)(bias1 + c + 4);
#pragma unroll
                for (int i = 0; i < 4; ++i) { v[jj * 8 + i] = (v[jj * 8 + i] - mean) * rstd * g0[i] + b0[i]; v[jj * 8 + 4 + i] = (v[jj * 8 + 4 + i] - mean) * rstd * g1[i] + b1[i];
                    ax = fmaxf(ax, fmaxf(fabsf(v[jj * 8 + i]), fabsf(v[jj * 8 + 4 + i]))); } }
            ax = fmaxf(wave_max(ax), 1e-20f);
            const float xs = 119.0f / ax;
            if (t < T) {
                if (lane == 0) *(f32x4*)(R4 + (size_t)t * 4) = (f32x4){ax * (1.0f / 119.0f) * (1.0f / U4_SCALE), mean, rstd, 0.f};
#pragma unroll
                for (int jj = 0; jj < 4; ++jj) { unsigned ph = 0u, pl = 0u;
#pragma unroll
                    for (int i = 0; i < 8; ++i) { const int x8 = (int)rintf(v[jj * 8 + i] * xs); const int lo = ((x8 + 8) & 15) - 8, hi = (x8 - lo) >> 4;
                        ph |= (unsigned)(hi & 15) << (4 * i); pl |= (unsigned)(lo & 15) << (4 * i); }
                    unsigned* dst = XQ + (size_t)t * 512 + (jj * 16 + (lane >> 2)) * 8 + (lane & 3);
                    dst[0] = ph; dst[4] = pl; }
            }
        }
    }
}

__device__ __forceinline__ void ph_gather_ln2(const Frame& F, int layer, int dummy = 0) {
    const unsigned char* UV4 = (const unsigned char*)(F.ws + WS_UB) + (size_t)layer * (2u * TAB4);
    const bf16* ZB = (const bf16*)(F.ws + WS_ZF); const bf16* PLE = (const bf16*)(F.ws + WS_PLE);
    const int* IDX = (const int*)(F.ws + WS_IDX); const float* GWt = (const float*)(F.ws + WS_GW);
    float* OF = (layer == 3 && !dummy) ? F.out : (float*)nullptr; bf16* XB = (bf16*)(F.ws + (dummy ? WS_X1B : WS_XB));
#ifdef PROBE_GATHER_MASK
    const int idmask = (dummy == 1) ? PROBE_GATHER_MASK : 0x3fff;
#endif
    const float* gain1 = F.ln_gain + (size_t)(layer * 2) * D; const float* bias1 = F.ln_bias + (size_t)(layer * 2) * D;
    const float* gain = F.ln_gain + (size_t)(layer * 2 + 1) * D; const float* bias = F.ln_bias + (size_t)(layer * 2 + 1) * D;
    const int lane = fresh_lane();
    const bool b3 = (lane & 8) != 0, b2 = (lane & 4) != 0, b1 = (lane & 2) != 0, b0 = (lane & 1) != 0;
    const __amdgpu_buffer_rsrc_t rs = __builtin_amdgcn_make_buffer_rsrc((void*)UV4, (short)0, (int)(2u * TAB4), 0x00020000);
    const unsigned voff = (unsigned)lane * 16u;
    v4u ring[16];
    int id0 = 0, id1 = 0, id0n = 0;
#define GATHER_ISSUE(k, sn_) do { const int sn = (sn_); const int secn = (sn >> 6) & 3; \
        const int idsel = (sn >= 256) ? id0n : ((secn & 1) ? id1 : id0); \
        const unsigned so = (unsigned)__builtin_amdgcn_readlane(idsel, sn & 63) * ROW4 + ((secn >= 2) ? TAB4 : 0u); \
        ring[k] = __builtin_bit_cast(v4u, __builtin_amdgcn_raw_buffer_load_b128(rs, voff, so, 0)); } while (0)
    int id1n = 0; float g0n = 0.f, g1n = 0.f;
    if (F.gw < T) { gather_sorted_ids(IDX, GWt, F.gw, lane, id0n, id1n, g0n, g1n);
#ifdef PROBE_GATHER_MASK
        id0n &= idmask; id1n &= idmask;
#endif
#pragma unroll
        for (int k = 0; k < 16; ++k) GATHER_ISSUE(k, 256 + k); }
    for (int t = F.gw; t < T; t += F.ngw) {
        int xh[4], xl[4]; float xdq, mean1, rstd1;
        {
            const v4u hq = *(const v4u*)(F.ws + WS_XQ + (size_t)t * 2048 + lane * 32), lq = *(const v4u*)(F.ws + WS_XQ + (size_t)t * 2048 + lane * 32 + 16);
            const f32x4 r4 = *(const f32x4*)(F.ws + WS_R4 + (size_t)t * 16);
            xh[0] = (int)hq.x; xh[1] = (int)hq.y; xh[2] = (int)hq.z; xh[3] = (int)hq.w; xl[0] = (int)lq.x; xl[1] = (int)lq.y; xl[2] = (int)lq.z; xl[3] = (int)lq.w;
            xdq = r4[0]; mean1 = r4[1]; rstd1 = r4[2];
        }
        if (t - F.wave + (NWAVES - 1) < T) __syncthreads();
        id0 = id0n; id1 = id1n; const float g0 = g0n, g1 = g1n;
        { const int tn = (t + F.ngw < T) ? t + F.ngw : t; gather_sorted_ids(IDX, GWt, tn, lane, id0n, id1n, g0n, g1n);
#ifdef PROBE_GATHER_MASK
          id0n &= idmask; id1n &= idmask;
#endif
        }
        float w0 = 0.f, w1 = 0.f;
#define GATHER_U_SECTION(SEC, GREG, WREG) \
        _Pragma("nounroll") for (int grp = 0; grp < 4; ++grp) { \
            const int s0 = (SEC) * 64 + grp * 16; \
            float P[16]; \
            _Pragma("unroll") for (int k = 0; k < 16; ++k) { \
                int ia = 0, ib = 0; \
                ia = __builtin_amdgcn_sdot8((int)ring[k].x, xh[0], ia, false); ib = __builtin_amdgcn_sdot8((int)ring[k].x, xl[0], ib, false); \
                ia = __builtin_amdgcn_sdot8((int)ring[k].y, xh[1], ia, false); ib = __builtin_amdgcn_sdot8((int)ring[k].y, xl[1], ib, false); \
                ia = __builtin_amdgcn_sdot8((int)ring[k].z, xh[2], ia, false); ib = __builtin_amdgcn_sdot8((int)ring[k].z, xl[2], ib, false); \
                ia = __builtin_amdgcn_sdot8((int)ring[k].w, xh[3], ia, false); ib = __builtin_amdgcn_sdot8((int)ring[k].w, xl[3], ib, false); \
                P[k] = (float)(16 * ia + ib); \
                GATHER_ISSUE(k, s0 + k + 16); __builtin_amdgcn_sched_barrier(0); } \
            _Pragma("unroll") for (int i = 0; i < 8; ++i) { const float keep = b3 ? P[i + 8] : P[i], send = b3 ? P[i] : P[i + 8]; P[i] = keep + shx(send, 8, lane); } \
            _Pragma("unroll") for (int i = 0; i < 4; ++i) { const float keep = b2 ? P[i + 4] : P[i], send = b2 ? P[i] : P[i + 4]; P[i] = keep + shx(send, 4, lane); } \
            _Pragma("unroll") for (int i = 0; i < 2; ++i) { const float keep = b1 ? P[i + 2] : P[i], send = b1 ? P[i] : P[i + 2]; P[i] = keep + shx(send, 2, lane); } \
            { const float keep = b0 ? P[1] : P[0], send = b0 ? P[0] : P[1]; P[0] = keep + shx(send, 1, lane); } \
            const float tot = xrow_sum(P[0]); \
            const float hid = tot * xdq; \
            const float ge = gelu_as(hid) * (1.0f / V4_SCALE); \
            if ((lane >> 4) == grp) WREG = GREG * ge; }
#define GATHER_TR4DOT(a0, a1, a2, a3, o) do { \
        const unsigned pa_ = __builtin_amdgcn_perm(a1, a0, 0x05010400u), pb_ = __builtin_amdgcn_perm(a1, a0, 0x07030602u), pc_ = __builtin_amdgcn_perm(a3, a2, 0x05010400u), pd_ = __builtin_amdgcn_perm(a3, a2, 0x07030602u); \
        const unsigned t0_ = __builtin_amdgcn_perm(pc_, pa_, 0x05040100u), t1_ = __builtin_amdgcn_perm(pc_, pa_, 0x07060302u), t2_ = __builtin_amdgcn_perm(pd_, pb_, 0x05040100u), t3_ = __builtin_amdgcn_perm(pd_, pb_, 0x07060302u); \
        acci[(o)]     = __builtin_amdgcn_sdot4((int)t0_, wpk, acci[(o)], false);     acci[(o) + 1] = __builtin_amdgcn_sdot4((int)(t0_ & 0xF0F0F0F0u), wpk, acci[(o) + 1], false); \
        acci[(o) + 2] = __builtin_amdgcn_sdot4((int)t1_, wpk, acci[(o) + 2], false); acci[(o) + 3] = __builtin_amdgcn_sdot4((int)(t1_ & 0xF0F0F0F0u), wpk, acci[(o) + 3], false); \
        acci[(o) + 4] = __builtin_amdgcn_sdot4((int)t2_, wpk, acci[(o) + 4], false); acci[(o) + 5] = __builtin_amdgcn_sdot4((int)(t2_ & 0xF0F0F0F0u), wpk, acci[(o) + 5], false); \
        acci[(o) + 6] = __builtin_amdgcn_sdot4((int)t3_, wpk, acci[(o) + 6], false); acci[(o) + 7] = __builtin_amdgcn_sdot4((int)(t3_ & 0xF0F0F0F0u), wpk, acci[(o) + 7], false); } while (0)
#define GATHER_V_SECTION(SEC, PKREG) \
        _Pragma("nounroll") for (int grp = 0; grp < 4; ++grp) { \
            const int s0 = (SEC) * 64 + grp * 16; \
            _Pragma("unroll") for (int sub = 0; sub < 4; ++sub) { \
                const int wpk = __builtin_amdgcn_readlane(PKREG, grp * 16 + sub * 4); \
                _Pragma("unroll") for (int q = 0; q < 4; ++q) { \
                    GATHER_TR4DOT(ring[4 * sub][q], ring[4 * sub + 1][q], ring[4 * sub + 2][q], ring[4 * sub + 3][q], 8 * q); } \
                _Pragma("unroll") for (int i = 0; i < 4; ++i) GATHER_ISSUE(4 * sub + i, s0 + 4 * sub + i + 16); \
                __builtin_amdgcn_sched_barrier(0); } }
        GATHER_U_SECTION(0, g0, w0)
        GATHER_U_SECTION(1, g1, w1)
        const float wm = wave_max(fmaxf(fabsf(w0), fabsf(w1)));
        const float wsq = (wm > 0.f) ? 127.0f / wm : 0.f;
        const int q0 = (int)rintf(w0 * wsq), q1 = (int)rintf(w1 * wsq);
        const int c8 = 8 * (int)wave_sum((float)(q0 + q1));
        const int pk0 = (q0 & 0xFF) | ((shl_i(q0, lane + 1) & 0xFF) << 8) | ((shl_i(q0, lane + 2) & 0xFF) << 16) | (shl_i(q0, lane + 3) << 24);
        const int pk1 = (q1 & 0xFF) | ((shl_i(q1, lane + 1) & 0xFF) << 8) | ((shl_i(q1, lane + 2) & 0xFF) << 16) | (shl_i(q1, lane + 3) << 24);
        int acci[32];
#pragma unroll
        for (int i = 0; i < 32; ++i) acci[i] = 0;
        GATHER_V_SECTION(2, pk0)
        GATHER_V_SECTION(3, pk1)
#undef GATHER_U_SECTION
#undef GATHER_V_SECTION
#undef GATHER_TR4DOT
        f32x2 acc[16];
        { const float fsc = wm * (1.0f / 127.0f);
#pragma unroll
          for (int i = 0; i < 16; ++i) acc[i] = (f32x2){(float)(acci[2 * i] - acci[2 * i + 1] - c8) * fsc, (float)acci[2 * i + 1] * (fsc * 0.0625f)}; }
        const int lane2 = ov(lane);
        float s = 0.f;
#pragma unroll
        for (int hh = 0; hh < 4; ++hh) { float pl[8]; unpack8(*(const v4u*)(PLE + (size_t)t * D + lane2 * 32 + hh * 8), pl);
            float z8[8]; unpack8(*(const v4u*)(ZB + (size_t)t * D + lane2 * 32 + hh * 8), z8);
            f32x4 xa = (f32x4){z8[0], z8[1], z8[2], z8[3]}, xb = (f32x4){z8[4], z8[5], z8[6], z8[7]};
            xa = (xa - mean1) * rstd1 * *(const f32x4*)(gain1 + lane2 * 32 + hh * 8) + *(const f32x4*)(bias1 + lane2 * 32 + hh * 8);
            xb = (xb - mean1) * rstd1 * *(const f32x4*)(gain1 + lane2 * 32 + hh * 8 + 4) + *(const f32x4*)(bias1 + lane2 * 32 + hh * 8 + 4);
            acc[hh * 4 + 0] += (f32x2){ALPHA * xa[0] + pl[0], ALPHA * xa[1] + pl[1]}; acc[hh * 4 + 1] += (f32x2){ALPHA * xa[2] + pl[2], ALPHA * xa[3] + pl[3]};
            acc[hh * 4 + 2] += (f32x2){ALPHA * xb[0] + pl[4], ALPHA * xb[1] + pl[5]}; acc[hh * 4 + 3] += (f32x2){ALPHA * xb[2] + pl[6], ALPHA * xb[3] + pl[7]};
#pragma unroll
            for (int i = 0; i < 4; ++i) s += acc[hh * 4 + i].x + acc[hh * 4 + i].y; }
        const float mean = wave_sum(s) * (1.0f / D); float q = 0.f;
#pragma unroll
        for (int i = 0; i < 16; ++i) { acc[i].x -= mean; acc[i].y -= mean; q += acc[i].x * acc[i].x + acc[i].y * acc[i].y; }
        const float rstd = ln_rstd(wave_sum(q));
#pragma unroll
        for (int hh = 0; hh < 4; ++hh) {
            const int c = lane2 * 32 + hh * 8;
            float y[8];
#pragma unroll
            for (int q4 = 0; q4 < 2; ++q4) { const f32x4 ga = *(const f32x4*)(gain + c + q4 * 4), ba = *(const f32x4*)(bias + c + q4 * 4);
                const f32x2 z0 = acc[hh * 4 + q4 * 2], z1 = acc[hh * 4 + q4 * 2 + 1];
                f32x4 yo; yo[0] = z0.x * rstd * ga[0] + ba[0]; yo[1] = z0.y * rstd * ga[1] + ba[1]; yo[2] = z1.x * rstd * ga[2] + ba[2]; yo[3] = z1.y * rstd * ga[3] + ba[3];
                if (OF) *(f32x4*)(OF + (size_t)t * D + c + q4 * 4) = yo;
                y[q4 * 4] = yo[0]; y[q4 * 4 + 1] = yo[1]; y[q4 * 4 + 2] = yo[2]; y[q4 * 4 + 3] = yo[3]; }
            if (!OF) *(v4u*)(XB + (size_t)t * D + c) = pack8(y);
#if MK_FP8_INPROJ
            acc[hh * 4 + 0] = (f32x2){y[0], y[1]}; acc[hh * 4 + 1] = (f32x2){y[2], y[3]}; acc[hh * 4 + 2] = (f32x2){y[4], y[5]}; acc[hh * 4 + 3] = (f32x2){y[6], y[7]};
#endif
        }
#if MK_FP8_INPROJ
        if (!dummy && !OF) {
            float am = 0.f;
#pragma unroll
            for (int i = 0; i < 16; ++i) am = fmaxf(am, fmaxf(fabsf(acc[i].x), fabsf(acc[i].y)));
            am = wave_max(am);
            const float inv = (am > 0.f) ? 127.0f / am : 0.f;
            if (lane2 == 0) ((float*)(F.ws + WS_SX))[t] = am * (1.0f / 127.0f);
#pragma unroll
            for (int hh = 0; hh < 4; ++hh) { v2u y8; y8.x = pk4_i8(acc[hh * 4].x * inv, acc[hh * 4].y * inv, acc[hh * 4 + 1].x * inv, acc[hh * 4 + 1].y * inv);
                y8.y = pk4_i8(acc[hh * 4 + 2].x * inv, acc[hh * 4 + 2].y * inv, acc[hh * 4 + 3].x * inv, acc[hh * 4 + 3].y * inv);
                *(v2u*)(F.ws + WS_X8 + (size_t)t * D + lane2 * 32 + hh * 8) = y8; }
        }
#endif
    }
#undef GATHER_ISSUE
}

constexpr size_t ML_BCUM = 0, ML_IPRE = 512 * 1024, ML_NLOC = 1024 * 1024, ML_BTOT = 1536 * 1024, ML_MLOC = 1540 * 1024, ML_MPREV = 1544 * 1024;
constexpr int ML_ROW = 272;
constexpr int ML_SM_OFF = 0, ML_K_OFF = 4096, ML_V_OFF = ML_K_OFF + 128 * ML_ROW;
static_assert(ML_V_OFF + 256 * ML_ROW <= RING_BYTES, "mLSTM LDS");

__device__ __forceinline__ void ml_stage_vt(const bf16* HB, int t0, int h, LAS unsigned char* lds, const LAS float* scl, int tid) {
#pragma unroll
    for (int i = 0; i < 4; ++i) {
        const int u = tid + 512 * i;
        const int sp = ((u >> 9) << 4) | (u & 15), ch = (u >> 4) & 31;
        const v4u a = *(const v4u*)(HB + (size_t)(t0 + 2 * sp) * 6144 + 2048 + h * 256 + ch * 8);
        const v4u b = *(const v4u*)(HB + (size_t)(t0 + 2 * sp + 1) * 6144 + 2048 + h * 256 + ch * 8);
        float fa[8], fb[8]; unpack8(a, fa); unpack8(b, fb);
        if (scl) { const float s0 = scl[2 * sp], s1 = scl[2 * sp + 1];
#pragma unroll
            for (int e = 0; e < 8; ++e) { fa[e] *= s0; fb[e] *= s1; } }
        LAS unsigned char* vb = lds + ML_V_OFF + (ch * 8) * ML_ROW + sp * 4;
#pragma unroll
        for (int e = 0; e < 8; ++e) *(LAS unsigned*)(vb + e * ML_ROW) = pk2(fa[e], fb[e]);
    }
}

__device__ __forceinline__ void ph_mlstm_gates(const Frame& F, int j) {
    const bf16* XB = (const bf16*)(F.ws + WS_XB); const bf16* WGB = (const bf16*)(F.ws + WS_WGB) + (size_t)j * 16 * 2048; float* GA = (float*)(F.ws + WS_GA);
    const int lane = fresh_lane(), l15 = lane & 15, g = lane >> 4;
    for (int task = F.gw; task < T / 16; task += F.ngw) {
        const bf16* xa = XB + (size_t)(task * 16 + l15) * D + 8 * g;
        const bf16* wb = WGB + (size_t)l15 * 2048 + 8 * g;
        f32x4 a0 = (f32x4){0.f, 0.f, 0.f, 0.f}, a1 = a0;
#pragma unroll 4
        for (int st = 0; st < 64; st += 2) {
            a0 = __builtin_amdgcn_mfma_f32_16x16x32_bf16(*(const bf16x8*)(xa + 32 * st), *(const bf16x8*)(wb + 32 * st), a0, 0, 0, 0);
            a1 = __builtin_amdgcn_mfma_f32_16x16x32_bf16(*(const bf16x8*)(xa + 32 * st + 32), *(const bf16x8*)(wb + 32 * st + 32), a1, 0, 0, 0);
        }
#pragma unroll
        for (int i = 0; i < 4; ++i) GA[(size_t)(task * 16 + 4 * g + i) * 16 + l15] = a0[i] + a1[i];
    }
}
__device__ __forceinline__ void ph_mlstm_local(const Frame& F, int j) {
    const bf16* HB = (const bf16*)(F.ws + WS_HB); const float* GA = (const float*)(F.ws + WS_GA);
    const float* gb = F.odd_gate_bias + j * 16;
    unsigned char* ml = F.ws + WS_ML;
    float* BCUM = (float*)(ml + ML_BCUM); float* IPRE = (float*)(ml + ML_IPRE); float* NLOC = (float*)(ml + ML_NLOC);
    float* BTOT = (float*)(ml + ML_BTOT); float* MLOC = (float*)(ml + ML_MLOC); bf16* CLOC = (bf16*)(F.ws + WS_CL);
    LAS unsigned char* lds = F.lds;
    LAS float* lf = (LAS float*)(lds + ML_SM_OFF); LAS float* bc = lf + 128; LAS float* wl = lf + 256; LAS float* al = lf + 384; LAS float* gi = lf + 512;
    const int tid = (F.wave * 64 + fresh_lane()), lane = tid & 63, wave = F.wave, l15 = lane & 15, g = lane >> 4;
    const float ksc = 0.08838834764831845f;
    for (int item = F.bid; item < 1024; item += F.nwg) {
        const int b = item / 512, h = (item / 64) % 8, c = item % 64;
        const int t0 = b * S + c * 128;
        __syncthreads();
        if (tid < 128) { const float* ga = GA + (size_t)(t0 + tid) * 16; gi[tid] = ga[h] + gb[h]; lf[tid] = logsig(ga[8 + h] + gb[8 + h]); }
        __syncthreads();
        {
            float a = (tid < 128) ? lf[tid] : 0.f;
#pragma unroll
            for (int d = 1; d < 64; d <<= 1) { const float o = __builtin_bit_cast(float, shl_i(__builtin_bit_cast(int, a), lane - d)); if (lane >= d) a += o; }
            if (tid == 63) wl[0] = a;
            __syncthreads();
            if (tid >= 64 && tid < 128) a += wl[0];
            if (tid < 128) bc[tid] = a;
        }
        __syncthreads();
        const float btot = bc[127];
        float wlv = -INFINITY;
        if (tid < 128) wlv = btot - bc[tid] + gi[tid];
        {   const float wm = wave_max(wlv); if (lane == 0 && wave < 2) wl[wave] = wm; }
        __syncthreads();
        const float mlv = fmaxf(wl[0], wl[1]);
        if (tid < 128) { al[tid] = __expf(wlv - mlv) * ksc; BCUM[(size_t)item * 128 + tid] = bc[tid]; IPRE[(size_t)item * 128 + tid] = gi[tid]; }
        if (tid == 0) { BTOT[item] = btot; MLOC[item] = mlv; }
        __syncthreads();
#pragma unroll
        for (int i = 0; i < 2; ++i) {
            const int u = tid + 512 * i;
            const int sp = ((u >> 8) << 4) | (u & 15), ch = (u >> 4) & 15;
            const v4u a = *(const v4u*)(HB + (size_t)(t0 + 2 * sp) * 6144 + 1024 + h * 128 + ch * 8);
            const v4u bq = *(const v4u*)(HB + (size_t)(t0 + 2 * sp + 1) * 6144 + 1024 + h * 128 + ch * 8);
            LAS unsigned char* kb = lds + ML_K_OFF + (ch * 8) * ML_ROW + sp * 4;
            *(LAS unsigned*)(kb + 0 * ML_ROW) = (a.x & 0xffffu) | (bq.x << 16);      *(LAS unsigned*)(kb + 1 * ML_ROW) = (a.x >> 16) | (bq.x & 0xffff0000u);
            *(LAS unsigned*)(kb + 2 * ML_ROW) = (a.y & 0xffffu) | (bq.y << 16);      *(LAS unsigned*)(kb + 3 * ML_ROW) = (a.y >> 16) | (bq.y & 0xffff0000u);
            *(LAS unsigned*)(kb + 4 * ML_ROW) = (a.z & 0xffffu) | (bq.z << 16);      *(LAS unsigned*)(kb + 5 * ML_ROW) = (a.z >> 16) | (bq.z & 0xffff0000u);
            *(LAS unsigned*)(kb + 6 * ML_ROW) = (a.w & 0xffffu) | (bq.w << 16);      *(LAS unsigned*)(kb + 7 * ML_ROW) = (a.w >> 16) | (bq.w & 0xffff0000u);
        }
        ml_stage_vt(HB, t0, h, lds, al, tid);
        __syncthreads();
        bf16x8 bfr[2][4];
#pragma unroll
        for (int vt = 0; vt < 2; ++vt)
#pragma unroll
            for (int st = 0; st < 4; ++st) bfr[vt][st] = *(const LAS bf16x8*)(lds + ML_V_OFF + (16 * (2 * wave + vt) + l15) * ML_ROW + 16 * g + 64 * st);
#pragma unroll
        for (int kt = 0; kt < 8; ++kt) {
            f32x4 c0 = (f32x4){0.f, 0.f, 0.f, 0.f}, c1 = (f32x4){0.f, 0.f, 0.f, 0.f};
#pragma unroll
            for (int st = 0; st < 4; ++st) {
                const bf16x8 af = *(const LAS bf16x8*)(lds + ML_K_OFF + (16 * kt + l15) * ML_ROW + 16 * g + 64 * st);
                c0 = __builtin_amdgcn_mfma_f32_16x16x32_bf16(af, bfr[0][st], c0, 0, 0, 0);
                c1 = __builtin_amdgcn_mfma_f32_16x16x32_bf16(af, bfr[1][st], c1, 0, 0, 0);
            }
            bf16* cp = CLOC + ((size_t)item * 256 + 16 * (2 * wave) + l15) * 128 + 16 * kt + 4 * g;
            v2u w0; w0.x = pk2(c0[0], c0[1]); w0.y = pk2(c0[2], c0[3]); *(v2u*)cp = w0;
            v2u w1; w1.x = pk2(c1[0], c1[1]); w1.y = pk2(c1[2], c1[3]); *(v2u*)(cp + 16 * 128) = w1;
        }
        if (tid < 128) {
            float n = 0.f;
            const LAS unsigned* kr = (const LAS unsigned*)(lds + ML_K_OFF + tid * ML_ROW);
            for (int sp = 0; sp < 64; ++sp) { const unsigned w = kr[sp]; n += al[2 * sp] * bflo(w) + al[2 * sp + 1] * bfhi(w); }
            NLOC[(size_t)item * 128 + tid] = n;
        }
    }
}

__device__ __forceinline__ void ph_mlstm_scan(const Frame& F) {
    unsigned char* ml = F.ws + WS_ML;
    float* NLOC = (float*)(ml + ML_NLOC); const float* BTOT = (const float*)(ml + ML_BTOT); const float* MLOC = (const float*)(ml + ML_MLOC);
    float* MPREV = (float*)(ml + ML_MPREV); unsigned* CL2 = (unsigned*)(F.ws + WS_CL);
    const int nthr = F.nwg * NTHREADS;
    for (int idx = F.bid * NTHREADS + (F.wave * 64 + fresh_lane()); idx < 16 * 16384; idx += nthr) {
        const int bh = idx / 16384, e = idx % 16384;
        const bool do_n = e < 128;
        float c0 = 0.f, c1 = 0.f, n = 0.f, m = 0.f;
#pragma unroll 1
        for (int ch0 = 0; ch0 < 64; ch0 += 16) {
            unsigned cl[16]; float nl[16];
#pragma unroll
            for (int j = 0; j < 16; ++j) { cl[j] = CL2[(size_t)(bh * 64 + ch0 + j) * 16384 + e]; nl[j] = do_n ? NLOC[(size_t)(bh * 64 + ch0 + j) * 128 + e] : 0.f; }
#pragma unroll
            for (int j = 0; j < 16; ++j) {
                const int item = bh * 64 + ch0 + j;
                const float bt = BTOT[item], mlv = MLOC[item];
                const float mn = fmaxf(bt + m, mlv);
                const float ao = __expf(bt + m - mn), an = __expf(mlv - mn);
                const unsigned prev = pk2(c0, c1); const float nprev = n;
                c0 = ao * c0 + an * bflo(cl[j]); c1 = ao * c1 + an * bfhi(cl[j]); n = ao * n + an * nl[j];
                cl[j] = prev; nl[j] = nprev;
                if (e == 0) MPREV[item] = m;
                m = mn;
            }
#pragma unroll
            for (int j = 0; j < 16; ++j) { CL2[(size_t)(bh * 64 + ch0 + j) * 16384 + e] = cl[j]; if (do_n) NLOC[(size_t)(bh * 64 + ch0 + j) * 128 + e] = nl[j]; }
        }
    }
}

constexpr int MLO_Q_OFF = ML_V_OFF + 256 * ML_ROW;
static_assert(MLO_Q_OFF + 128 * ML_ROW <= RING_BYTES, "mLSTM out LDS");
__device__ __forceinline__ void mlo_issue(const bf16* HB, int item, int tid, v4u (&kq)[8], v4u (&pva)[4], v4u (&pvb)[4]) {
    const int b = item / 512, h = (item / 64) % 8, c = item % 64, t0 = b * S + c * 128;
#pragma unroll
    for (int i = 0; i < 4; ++i) { const int u = tid + 512 * i, r = u >> 4, ch = u & 15;
        kq[2 * i] = *(const v4u*)(HB + (size_t)(t0 + r) * 6144 + 1024 + h * 128 + ch * 8);
        kq[2 * i + 1] = *(const v4u*)(HB + (size_t)(t0 + r) * 6144 + h * 128 + ch * 8); }
#pragma unroll
    for (int i = 0; i < 4; ++i) { const int u = tid + 512 * i; const int sp = ((u >> 9) << 4) | (u & 15), ch = (u >> 4) & 31;
        pva[i] = *(const v4u*)(HB + (size_t)(t0 + 2 * sp) * 6144 + 2048 + h * 256 + ch * 8);
        pvb[i] = *(const v4u*)(HB + (size_t)(t0 + 2 * sp + 1) * 6144 + 2048 + h * 256 + ch * 8); }
}
__device__ __forceinline__ void ph_mlstm_out(const Frame& F) {
    const bf16* HB = (const bf16*)(F.ws + WS_HB); bf16* YB = (bf16*)(F.ws + WS_YB);
    unsigned char* ml = F.ws + WS_ML;
    const float* BCUM = (const float*)(ml + ML_BCUM); const float* IPRE = (const float*)(ml + ML_IPRE); const float* NPREV = (const float*)(ml + ML_NLOC);
    const float* MPREV = (const float*)(ml + ML_MPREV); const bf16* CPREV = (const bf16*)(F.ws + WS_CL);
    LAS unsigned char* lds = F.lds;
    LAS float* bc = (LAS float*)(lds + ML_SM_OFF); LAS float* ipr = bc + 128; LAS float* np = bc + 256; LAS float* mts = bc + 384; LAS float* dd = bc + 512; LAS float* ais = bc + 640; LAS float* rds = bc + 768;
    const int tid = (F.wave * 64 + fresh_lane()), lane = tid & 63, wave = F.wave, l15 = lane & 15, g = lane >> 4;
    const float ksc = 0.08838834764831845f;
    v4u kq[8], pva[4], pvb[4];
    if (F.bid < 1024) mlo_issue(HB, F.bid, tid, kq, pva, pvb);
    for (int item = F.bid; item < 1024; item += F.nwg) {
        const int b = item / 512, h = (item / 64) % 8, c = item % 64;
        const int t0 = b * S + c * 128;
        bf16x8 cf[2][4];
#pragma unroll
        for (int vt = 0; vt < 2; ++vt)
#pragma unroll
            for (int st = 0; st < 4; ++st) cf[vt][st] = *(const bf16x8*)(CPREV + ((size_t)item * 256 + 16 * (2 * wave + vt) + l15) * 128 + 8 * g + 32 * st);
        __syncthreads();
        if (tid < 128) { const float bv = BCUM[(size_t)item * 128 + tid], iv = IPRE[(size_t)item * 128 + tid]; bc[tid] = bv; ipr[tid] = iv; dd[tid] = iv - bv; np[tid] = NPREV[(size_t)item * 128 + tid]; }
        const float mprev = MPREV[item];
#pragma unroll
        for (int i = 0; i < 4; ++i) {
            const int u = tid + 512 * i, r = u >> 4, ch = u & 15;
            *(LAS v4u*)(lds + ML_K_OFF + r * ML_ROW + ch * 16) = kq[2 * i];
            *(LAS v4u*)(lds + MLO_Q_OFF + r * ML_ROW + ch * 16) = kq[2 * i + 1];
        }
#pragma unroll
        for (int i = 0; i < 4; ++i) {
            const int u = tid + 512 * i; const int sp = ((u >> 9) << 4) | (u & 15), ch = (u >> 4) & 31;
            const v4u a = pva[i], bq = pvb[i];
            LAS unsigned char* vbp = lds + ML_V_OFF + (ch * 8) * ML_ROW + sp * 4;
            *(LAS unsigned*)(vbp + 0 * ML_ROW) = (a.x & 0xffffu) | (bq.x << 16);      *(LAS unsigned*)(vbp + 1 * ML_ROW) = (a.x >> 16) | (bq.x & 0xffff0000u);
            *(LAS unsigned*)(vbp + 2 * ML_ROW) = (a.y & 0xffffu) | (bq.y << 16);      *(LAS unsigned*)(vbp + 3 * ML_ROW) = (a.y >> 16) | (bq.y & 0xffff0000u);
            *(LAS unsigned*)(vbp + 4 * ML_ROW) = (a.z & 0xffffu) | (bq.z << 16);      *(LAS unsigned*)(vbp + 5 * ML_ROW) = (a.z >> 16) | (bq.z & 0xffff0000u);
            *(LAS unsigned*)(vbp + 6 * ML_ROW) = (a.w & 0xffffu) | (bq.w << 16);      *(LAS unsigned*)(vbp + 7 * ML_ROW) = (a.w >> 16) | (bq.w & 0xffff0000u);
        }
        __syncthreads();
        {
            float pm = (tid < 128) ? dd[tid] : -INFINITY;
#pragma unroll
            for (int d = 1; d < 64; d <<= 1) { const float o = __builtin_bit_cast(float, shl_i(__builtin_bit_cast(int, pm), lane - d)); if (lane >= d) pm = fmaxf(pm, o); }
            if (tid == 63) ais[0] = pm;
            __syncthreads();
            if (tid >= 64 && tid < 128) pm = fmaxf(pm, ais[0]);
            if (tid < 128) mts[tid] = fmaxf(bc[tid] + mprev, bc[tid] + pm);
        }
        __syncthreads();
        const int tq = 16 * wave + l15;
        v2u pw[8];
        {
            bf16x8 qf[4];
#pragma unroll
            for (int st = 0; st < 4; ++st) qf[st] = *(const LAS bf16x8*)(lds + MLO_Q_OFF + tq * ML_ROW + 16 * g + 64 * st);
            const float bct = bc[tq], mt = mts[tq];
            const float ai = __expf(bct + mprev - mt);
            float dsum = 0.f;
#pragma unroll
            for (int kt = 0; kt < 8; ++kt) {
                f32x4 sa = (f32x4){0.f, 0.f, 0.f, 0.f};
                if (kt <= wave) {
#pragma unroll
                    for (int st = 0; st < 4; ++st) sa = __builtin_amdgcn_mfma_f32_16x16x32_bf16(*(const LAS bf16x8*)(lds + ML_K_OFF + (16 * kt + l15) * ML_ROW + 16 * g + 64 * st), qf[st], sa, 0, 0, 0);
                    const f32x4 d4 = *(const LAS f32x4*)&dd[16 * kt + 4 * g];
#pragma unroll
                    for (int i = 0; i < 4; ++i) { const int s = 16 * kt + 4 * g + i; const float v = (s <= tq) ? sa[i] * ksc * __expf(bct + d4[i] - mt) : 0.f; sa[i] = v; dsum += v; }
                }
                pw[kt].x = pk2(sa[0], sa[1]); pw[kt].y = pk2(sa[2], sa[3]);
            }
            dsum = xrow_sum(dsum);
            float nq = 0.f;
#pragma unroll
            for (int st = 0; st < 4; ++st) { float qv[8]; unpack8(__builtin_bit_cast(v4u, qf[st]), qv);
                const f32x4 n0 = *(const LAS f32x4*)&np[32 * st + 8 * g], n1 = *(const LAS f32x4*)&np[32 * st + 8 * g + 4];
                nq += qv[0] * n0[0] + qv[1] * n0[1] + qv[2] * n0[2] + qv[3] * n0[3] + qv[4] * n1[0] + qv[5] * n1[1] + qv[6] * n1[2] + qv[7] * n1[3]; }
            nq = xrow_sum(nq);
            const float den = ai * nq + dsum;
            if (g == 0) { ais[tq] = ai; rds[tq] = 1.0f / fmaxf(fabsf(den), __expf(-mt)); }
        }
        __syncthreads();
#pragma unroll
        for (int kt = 0; kt < 8; ++kt) *(LAS v2u*)(lds + ML_K_OFF + tq * ML_ROW + (16 * kt + 4 * g) * 2) = pw[kt];
        __syncthreads();
        if (item + F.nwg < 1024) mlo_issue(HB, item + F.nwg, tid, kq, pva, pvb);
        const bf16* ogp = HB + (size_t)(t0 + l15) * 6144 + 4096 + h * 256 + 32 * wave + 4 * g;
        v2u ogn0 = *(const v2u*)ogp, ogn1 = *(const v2u*)(ogp + 16);
#pragma unroll
        for (int tt = 0; tt < 8; ++tt) {
            const int t = 16 * tt + l15;
            const v2u ogc[2] = {ogn0, ogn1};
            if (tt < 7) { ogn0 = *(const v2u*)(ogp + (size_t)(16 * (tt + 1)) * 6144); ogn1 = *(const v2u*)(ogp + (size_t)(16 * (tt + 1)) * 6144 + 16); }
            bf16x8 qf[4];
#pragma unroll
            for (int st = 0; st < 4; ++st) qf[st] = *(const LAS bf16x8*)(lds + MLO_Q_OFF + t * ML_ROW + 16 * g + 64 * st);
            const int nst = (tt >> 1) + 1;
            bf16x8 pf[4];
#pragma unroll
            for (int st = 0; st < 4; ++st) if (st < nst) pf[st] = *(const LAS bf16x8*)(lds + ML_K_OFF + t * ML_ROW + 16 * g + 64 * st);
            const float ai = ais[t], rd = rds[t];
#pragma unroll
            for (int vt = 0; vt < 2; ++vt) {
                f32x4 ci = (f32x4){0.f, 0.f, 0.f, 0.f}, cx = (f32x4){0.f, 0.f, 0.f, 0.f};
#pragma unroll
                for (int st = 0; st < 4; ++st) ci = __builtin_amdgcn_mfma_f32_16x16x32_bf16(cf[vt][st], qf[st], ci, 0, 0, 0);
                const LAS unsigned char* vr = lds + ML_V_OFF + (16 * (2 * wave + vt) + l15) * ML_ROW + 16 * g;
#pragma unroll
                for (int st = 0; st < 4; ++st) if (st < nst) cx = __builtin_amdgcn_mfma_f32_16x16x32_bf16(*(const LAS bf16x8*)(vr + 64 * st), pf[st], cx, 0, 0, 0);
                const int vcol = h * 256 + 16 * (2 * wave + vt) + 4 * g;
                const v2u ogw = ogc[vt];
                const float y0 = (ai * ci[0] + cx[0]) * rd * sigmoidf_(bflo(ogw.x)), y1 = (ai * ci[1] + cx[1]) * rd * sigmoidf_(bfhi(ogw.x));
                const float y2 = (ai * ci[2] + cx[2]) * rd * sigmoidf_(bflo(ogw.y)), y3 = (ai * ci[3] + cx[3]) * rd * sigmoidf_(bfhi(ogw.y));
                v2u w; w.x = pk2(y0, y1); w.y = pk2(y2, y3);
                *(v2u*)(YB + (size_t)(t0 + t) * 2048 + vcol) = w;
            }
        }
    }
}
struct Args { const void* in[17]; float* out; unsigned char* ws; int ph_lo, ph_hi; };
constexpr int PH_PER_LAYER = 9, N_PHASES = 1 + 4 * PH_PER_LAYER;

__global__ void __launch_bounds__(NTHREADS, 2) mk_fwd(Args args) {
    extern __shared__ __attribute__((aligned(16))) unsigned char lds_raw[];
    Frame F0;
#define F F0
    F.lds = (LAS unsigned char*)lds_raw;
    F.tid = threadIdx.x; F.lane = F.tid & 63; F.wave = __builtin_amdgcn_readfirstlane(F.tid >> 6);
    F.gw = blockIdx.x * NWAVES + F.wave; F.ngw = gridDim.x * NWAVES; F.bid = (int)blockIdx.x; F.nwg = (int)gridDim.x;
    F.x = (const float*)args.in[0]; F.p = (const float*)args.in[1]; F.pos = (const int*)args.in[2];
    F.even_w_in = (const float*)args.in[3]; F.even_conv_w = (const float*)args.in[4]; F.even_w_out = (const float*)args.in[5];
    F.odd_w_in = (const float*)args.in[6]; F.odd_gate_bias = (const float*)args.in[7]; F.odd_w_out = (const float*)args.in[8];
    F.peer_w_q = (const float*)args.in[9]; F.peer_sub_keys = (const float*)args.in[10]; F.peer_u = (const float*)args.in[11]; F.peer_v = (const float*)args.in[12];
    F.ple_w_proj = (const float*)args.in[13]; F.ple_w_gate = (const float*)args.in[14]; F.ln_gain = (const float*)args.in[15]; F.ln_bias = (const float*)args.in[16];
    F.out = args.out; F.ws = args.ws;
    unsigned char* ws0_ = args.ws;
    for (int u = F.tid; u < (LDS_BYTES - LDSCTL_OFF) / 4; u += NTHREADS) ((LAS unsigned*)(F.lds + LDSCTL_OFF))[u] = 0u;
    __syncthreads();
    XcdBarrier bar = xcd_barrier_post((unsigned*)(ws0_ + WS_CTL) + CW_BAR, (volatile LAS unsigned*)(F.lds + MISC_OFF) + 8);
    const int lo = args.ph_lo, hi = args.ph_hi;
#ifndef PROBE_REP_MASK
#define PROBE_REP_MASK 0
#endif
#define PH_REP(k) for (int rep_ = 0; rep_ < (((PROBE_REP_MASK >> (k)) & 1) ? 2 : 1); ++rep_)
#define PH_IN(id) (lo <= (id) && (id) < hi)
#define PH_SEAM(id) do { if ((id) + 1 < hi) xcd_barrier(bar, F.wave == 0 && fresh_lane() == 0); } while (0)

#if MK_FP8_INPROJ
    if (PH_IN(0)) { p0_prologue(F); xcd_barrier(bar, F.wave == 0 && fresh_lane() == 0); p0_prologue_b(F); PH_SEAM(0); }
#else
    if (PH_IN(0)) { PH_REP(9) { p0_prologue(F); } PH_SEAM(0); }
#endif
#undef F

    for (int layer_ = 0; layer_ < DEPTH; ++layer_) {
        int layer = layer_; asm volatile("" : "+s"(layer));
        GAS unsigned char* wsg_ = (GAS unsigned char*)args.ws; asm volatile("" : "+s"(wsg_));
        unsigned char* wsl_ = (unsigned char*)wsg_;
        Frame FL = F0; FL.ws = wsl_;
        asm volatile("" : "+s"(FL.bid), "+s"(FL.nwg), "+s"(FL.wave));
        FL.gw = FL.bid * NWAVES + FL.wave; FL.ngw = FL.nwg * NWAVES;
        const Frame& F = FL; unsigned char* const ws = wsl_;
        const int pb = 1 + layer * PH_PER_LAYER;
        const int j = layer >> 1;
        const bool even = (layer & 1) == 0;
        if (PH_IN(pb + 0)) { PH_REP(0) {
#if MK_FP8_INPROJ
            { pg8::Gemm g{(const bf16*)(ws + WS_X8), (const bf16*)(ws + WS_WIN + (size_t)layer * 6144 * 2048), T, 6144, 1024};
              pg8::StaticOrder So; So.init(T, 6144, F.nwg, F.bid);
              EpiPlainI8 E{(bf16*)(ws + WS_HB), 6144, (const float*)(ws + WS_SX), (const float*)(ws + WS_SW) + layer * 6144};
              pg8::gemm_phase<EpiPlainI8, pg8::StaticOrder, true, true, true>(F.lds + RING_OFF, g, So, E, F.wave * 64 + fresh_lane()); }
#else
            { pg8::Gemm g{(const bf16*)(ws + WS_XB), (const bf16*)(ws + WS_WIN) + (size_t)layer * 6144 * 2048, T, 6144, 2048};
              pg8::StaticOrder So; So.init(T, 6144, F.nwg, F.bid);
              EpiPlain E{(bf16*)(ws + WS_HB), 6144};
              pg8::gemm_phase<EpiPlain, pg8::StaticOrder, true, true>(F.lds + RING_OFF, g, So, E, F.wave * 64 + fresh_lane()); }
#endif
            { pg8::Gemm g{(const bf16*)(ws + WS_PB) + (size_t)layer * T * 256, (const bf16*)(ws + WS_WPJ) + (size_t)layer * 2048 * 256, T, 2048, 256};
              pg8::StaticOrder So; So.init(T, 2048, F.nwg, F.bid);
              EpiPlain E{(bf16*)(ws + WS_PJ), 2048};
              pg8::gemm_phase<EpiPlain, pg8::StaticOrder, true, true>(F.lds + RING_OFF, g, So, E, F.wave * 64 + fresh_lane()); }
            if (!even) ph_mlstm_gates(F, j);
            ph_c12(F, layer); }
            PH_SEAM(pb + 0);
        }
        if (even) {
            if (PH_IN(pb + 1)) { ph_rope_conv(F, j); PH_SEAM(pb + 1); }
            if (PH_IN(pb + 2)) { PH_REP(2) { ph_attn_mfma(F); } PH_SEAM(pb + 2); }
            if (PH_IN(pb + 3)) { PH_REP(10) { ph_attn_combine(F); } PH_SEAM(pb + 3); }
        } else {
            if (PH_IN(pb + 1)) { PH_REP(1) { ph_mlstm_local(F, j); } PH_SEAM(pb + 1); }
            if (PH_IN(pb + 2)) { ph_mlstm_scan(F); PH_SEAM(pb + 2); }
#if MK_FP8_INPROJ
            if (PH_IN(pb + 3)) { ph_mlstm_out(F); xcd_barrier(bar, F.wave == 0 && fresh_lane() == 0); ph_quant_y(F); PH_SEAM(pb + 3); }
#else
            if (PH_IN(pb + 3)) { PH_REP(3) { ph_mlstm_out(F); } PH_SEAM(pb + 3); }
#endif
        }
#if MK_FP8_INPROJ
        if (PH_IN(pb + 4)) {
            pg8::Gemm g{(const bf16*)(ws + WS_Y8), (const bf16*)(ws + WS_WOUT + (size_t)layer * 2048 * 2048), T, 2048, 1024};
            pg8::StaticOrder So; So.init(T, 2048, F.nwg, F.bid);
            EpiZ8 E{(bf16*)(ws + WS_ZF), (const float*)nullptr, (const bf16*)(ws + WS_XB), (const float*)(ws + WS_SY), (const float*)(ws + WS_SWO) + (size_t)layer * 2048};
            pg8::gemm_phase<EpiZ8, pg8::StaticOrder, true, true, true>(F.lds + RING_OFF, g, So, E, F.wave * 64 + fresh_lane());
            PH_SEAM(pb + 4);
        }
#else
        if (PH_IN(pb + 4)) {
            pg8::Gemm g{(const bf16*)(ws + WS_YB), (const bf16*)(ws + WS_WOUT) + (size_t)layer * 2048 * 2048, T, 2048, 2048};
            pg8::StaticOrder So; So.init(T, 2048, F.nwg, F.bid);
            EpiZ E{(bf16*)(ws + WS_ZF), (layer == 0) ? F.x : (const float*)nullptr, (const bf16*)(ws + WS_XB), (float*)(ws + WS_PST)};
            PH_REP(4) { pg8::gemm_phase<EpiZ, pg8::StaticOrder, true, true>(F.lds + RING_OFF, g, So, E, F.wave * 64 + fresh_lane()); }
            PH_SEAM(pb + 4);
        }
#endif
#if MK_FP8_INPROJ
        if (PH_IN(pb + 5)) { ph_quant_z(F, layer); PH_SEAM(pb + 5); }
        if (PH_IN(pb + 6)) {
            pg8::Gemm g{(const bf16*)(ws + WS_Z8), (const bf16*)(ws + WS_WQG + (size_t)layer * 4096 * 2048), T, 4096, 1024};
            pg8::StaticOrder So; So.init(T, 4096, F.nwg, F.bid);
            EpiQG8 E{(bf16*)(ws + WS_QB), (const bf16*)(ws + WS_PJ), (bf16*)(ws + WS_PLE), (const float*)(ws + WS_C12) + (size_t)layer * 4096 * 2, (const float*)(ws + WS_RS), (const float*)(ws + WS_SWQ) + (size_t)layer * 4096};
            pg8::gemm_phase<EpiQG8, pg8::StaticOrder, true, true, true>(F.lds + RING_OFF, g, So, E, F.wave * 64 + fresh_lane());
            PH_SEAM(pb + 6);
        }
#else
        if (PH_IN(pb + 6)) {
            pg8::Gemm g{(const bf16*)(ws + WS_ZF), (const bf16*)(ws + WS_WQG) + (size_t)layer * 4096 * 2048, T, 4096, 2048};
            pg8::StaticOrder So; So.init(T, 4096, F.nwg, F.bid);
            int pmr0, pmr1, pmr2; ln1_row_stats(F, So, pmr0, pmr1, pmr2);
            EpiQG E{(bf16*)(ws + WS_QB), (const bf16*)(ws + WS_PJ), (bf16*)(ws + WS_PLE), (const float*)(ws + WS_C12) + (size_t)layer * 4096 * 2, (LAS const float*)(F.lds + STAT_OFF), pmr0, pmr1, pmr2};
            PH_REP(6) { pg8::gemm_phase<EpiQG, pg8::StaticOrder, true, true>(F.lds + RING_OFF, g, So, E, F.wave * 64 + fresh_lane()); }
            PH_SEAM(pb + 6);
        }
#endif
        if (PH_IN(pb + 7)) { PH_REP(7) { ph_topk(F, layer); } PH_SEAM(pb + 7); }
#ifdef PROBE_GATHER_MASK
        if (PH_IN(pb + 8)) { ph_gather_ln2(F, layer, 1); __syncthreads(); ph_gather_ln2(F, layer, 0); PH_SEAM(pb + 8); }
#else
        if (PH_IN(pb + 8)) { PH_REP(8) { ph_gather_ln2(F, layer); } PH_SEAM(pb + 8); }
#endif
    }
#undef PH_IN
#undef PH_SEAM
}

#ifndef MK_ONE_LAUNCH
#define MK_ONE_LAUNCH 1
#endif
static void run(void* const* d_in, float* out, unsigned char* ws, size_t ws_size, hipStream_t stream) {
    static int ready = 0, grid = 256;
    if (!ready) {
        if (ws_size < WS_END) { fprintf(stderr, "mk: workspace too small (%zu < %zu)\n", ws_size, (size_t)WS_END); ready = -1; return; }
        if (hipFuncSetAttribute((const void*)mk_fwd, hipFuncAttributeMaxDynamicSharedMemorySize, LDS_BYTES) != hipSuccess) { fprintf(stderr, "mk: hipFuncSetAttribute failed\n"); ready = -1; return; }
        int dev = 0, cus = 0;
        if (hipGetDevice(&dev) == hipSuccess && hipDeviceGetAttribute(&cus, hipDeviceAttributeMultiprocessorCount, dev) == hipSuccess && cus > 0 && cus < 256) grid = (cus / 8) * 8 > 0 ? (cus / 8) * 8 : cus;
        (void)hipGetLastError();
        ready = 1;
    }
    if (ready < 0) return;
    (void)hipMemsetAsync(ws + WS_CTL, 0, CTL_ZERO_BYTES, stream);
    Args a; memset(&a, 0, sizeof(a));
    for (int i = 0; i < 17; ++i) a.in[i] = d_in[i];
    a.out = out; a.ws = ws;
#if MK_ONE_LAUNCH
    a.ph_lo = 0; a.ph_hi = N_PHASES;
    hipLaunchKernelGGL(mk_fwd, dim3(grid), dim3(NTHREADS), LDS_BYTES, stream, a);
#else
    for (int ph = 0; ph < N_PHASES; ++ph) {
        if (ph > 0) { const int layer = (ph - 1) / PH_PER_LAYER, k = (ph - 1) % PH_PER_LAYER;  }
        a.ph_lo = ph; a.ph_hi = ph + 1;
        hipLaunchKernelGGL(mk_fwd, dim3(grid), dim3(NTHREADS), LDS_BYTES, stream, a);
    }
#endif
    const hipError_t le = hipPeekAtLastError();
    if (le != hipSuccess) fprintf(stderr, "mk: launch failed: %s\n", hipGetErrorName(le));
}
}

extern "C" void kernel_launch(void* const* d_in, const int* in_sizes, int n_in,
                              void* d_out, int out_size, void* d_ws, size_t ws_size,
                              hipStream_t stream) {
    (void)in_sizes; (void)n_in; (void)out_size;
    mk::run(d_in, (float*)d_out, (unsigned char*)d_ws, ws_size, stream);
}
```

```cpp
#include <hip/hip_runtime.h>
#include <cstdio>
#include <cstring>
#include <cstdint>
#include <cmath>
#define MK_ONE_LAUNCH 1
#define MK_FP8_INPROJ 1
namespace pg8 {
#define PG8_LAS __attribute__((address_space(3)))
typedef unsigned short bf16_t;
typedef short bf16x8 __attribute__((ext_vector_type(8)));
typedef float f32x4 __attribute__((ext_vector_type(4)));
typedef unsigned u32x4 __attribute__((ext_vector_type(4)));
constexpr int BM = 256, BK = 64, HALF = 128, HTB = HALF * BK * 2  , STAGE_BYTES = 8 * HTB, NXCD = 8, WGM = 8;

__host__ __device__ __forceinline__ int lds_byte(int r, int c) { const int st = (r >> 4) * 2 + (c >> 5), rr = r & 15, cc = c & 31, ob = rr * 64 + cc * 2; return st * 1024 + (ob ^ (((ob >> 9) & 1) << 5)); }
__host__ __device__ __forceinline__ void stage_rc(int b, int& R, int& C) { const int st = b / 1024, sb = b % 1024, swz = sb ^ (((sb >> 9) & 1) << 5); R = (st >> 1) * 16 + swz / 64; C = (st & 1) * 32 + (swz % 64) / 2; }
__host__ __device__ __forceinline__ int perm32(int rho) { const int n = rho >> 4, i = rho & 15; return 8 * (i >> 2) + 4 * n + (i & 3); }

struct Unit { int pm, pn; };
struct Gemm { const bf16_t* A; const bf16_t* Bt; int M, N, K; };

struct StaticOrder {
    int nM, nN, nwg, G, c;
    __host__ __device__ void init(int M, int N, int G_, int c_) { nM = M / BM; nN = N / BM; nwg = nM * nN; G = G_; c = c_; }
    __host__ __device__ bool next(int i, Unit& u) const {
        const long L = (long)i * G + c; if (L >= nwg) return false;
        int wgid = (int)L; { const int q = nwg / NXCD, r = nwg % NXCD, xcd = wgid % NXCD, off = wgid / NXCD; wgid = (xcd < r ? xcd * (q + 1) : r * (q + 1) + (xcd - r) * q) + off; }
        const int nig = WGM * nN, gid = wgid / nig, fm = gid * WGM, gsz = (nM - fm) < WGM ? (nM - fm) : WGM;
        u.pm = fm + ((wgid % nig) % gsz); u.pn = (wgid % nig) / gsz; return true;
    }
    __device__ __forceinline__ void a_ready(const Unit&) const {}
    __device__ __forceinline__ void done(const Unit&) const {}
};

__device__ __forceinline__ unsigned cvt_pk_bf16(float lo, float hi) { unsigned r; asm volatile("v_cvt_pk_bf16_f32 %0, %1, %2" : "=v"(r) : "v"(lo), "v"(hi)); return r; }
template <class Epi, class Sched, bool ALIGN_EPI = false, bool SP2 = false, bool FP8 = false>
__device__ __forceinline__ void gemm_phase(PG8_LAS unsigned char* lds, const Gemm g, const Sched& S, const Epi& E, const int tid_in) {
    const int tid = tid_in, wid = __builtin_amdgcn_readfirstlane(tid >> 6), lane = tid & 63, wr = wid >> 2, wc = wid & 3, fr = lane & 15, fq = lane >> 4;
    const int K = g.K, nt = K / BK;
    unsigned voffA[2], voffB[2];
#pragma unroll
    for (int i = 0; i < 2; ++i) { int R, C; stage_rc(tid * 16 + i * 8192, R, C); const int Rb = Epi::PERM ? ((R & ~31) + perm32(R & 31)) : R;
        voffA[i] = (unsigned)(R * K + C) * 2u; voffB[i] = (unsigned)(Rb * K + C) * 2u; }
    const size_t kstep = (size_t)(BK * 2);
    const size_t hstep = (size_t)HALF * K * 2;
    const size_t tstep = 2 * hstep;
    const unsigned ldsw = (unsigned)wid * 1024u;
    const int aoff = lds_byte(wr * 64 + fr, fq * 8), boff = lds_byte(wc * 32 + fr, fq * 8);
#define PG8_SA(b, h) (((b) * 2 + (h)) * HTB)
#define PG8_SB(b, h) ((4 + (b) * 2 + (h)) * HTB)
#define PG8_STAGE(bufoff, gbase, voff) do { _Pragma("unroll") for (int _i = 0; _i < 2; ++_i) { unsigned vo_ = (voff)[_i]; asm volatile("" : "+v"(vo_));   \
        __builtin_amdgcn_global_load_lds((const unsigned*)((const char*)(gbase) + vo_), (PG8_LAS unsigned*)(lds + (bufoff) + ldsw + _i * 8192), 16, 0, 0); } } while (0)
#define PG8_LDA(dst, b, h) do { _Pragma("unroll") for (int m = 0; m < 4; ++m) _Pragma("unroll") for (int k = 0; k < 2; ++k) dst[m][k] = *(const PG8_LAS bf16x8*)(lds + PG8_SA(b, h) + aoff + m * 2048 + k * 1024); } while (0)
#define PG8_LDB(dst, b, h) do { _Pragma("unroll") for (int n = 0; n < 2; ++n) _Pragma("unroll") for (int k = 0; k < 2; ++k) dst[n][k] = *(const PG8_LAS bf16x8*)(lds + PG8_SB(b, h) + boff + n * 2048 + k * 1024); } while (0)
#define PG8_MMA(ai, bj, At, Bt) do { __builtin_amdgcn_s_setprio(1); \
        if constexpr (FP8) {   \
            _Pragma("unroll") for (int m = 0; m < 4; ++m) _Pragma("unroll") for (int n = 0; n < 2; ++n) _Pragma("unroll") for (int k = 0; k < 2; ++k) \
                acc[ai][bj][m][n] = __builtin_bit_cast(f32x4, __builtin_amdgcn_mfma_i32_16x16x64_i8(__builtin_bit_cast(pg8_i4, Bt[n][k]), __builtin_bit_cast(pg8_i4, At[m][k]), __builtin_bit_cast(pg8_i4, acc[ai][bj][m][n]), 0, 0, 0)); \
        } else { \
        _Pragma("unroll") for (int m = 0; m < 4; ++m) _Pragma("unroll") for (int n = 0; n < 2; ++n) _Pragma("unroll") for (int k = 0; k < 2; ++k) \
        acc[ai][bj][m][n] = __builtin_amdgcn_mfma_f32_16x16x32_bf16(Bt[n][k], At[m][k], acc[ai][bj][m][n], 0, 0, 0); } __builtin_amdgcn_s_setprio(0); } while (0)
#define PG8_WAIT_V(n) asm volatile("s_waitcnt vmcnt(" #n ")" ::: "memory")
#define PG8_WAIT_L(n) asm volatile("s_waitcnt lgkmcnt(" #n ")" ::: "memory")
#define PG8_BAR __builtin_amdgcn_s_barrier()
#define PG8_SCHED __builtin_amdgcn_sched_barrier(0)
    Unit cur, nxt; int ui = 0;
    if (!S.next(0, cur)) return;
    f32x4 acc[2][2][4][2];
    { float z_ = 0.f; asm volatile("" : "+v"(z_));
#pragma unroll
    for (int a = 0; a < 2; ++a)
#pragma unroll
        for (int b = 0; b < 2; ++b)
#pragma unroll
            for (int m = 0; m < 4; ++m)
#pragma unroll
                for (int n = 0; n < 2; ++n) acc[a][b][m][n] = (f32x4){z_, z_, z_, z_}; }
    typedef int pg8_i4 __attribute__((ext_vector_type(4))); typedef long pg8_l2 __attribute__((ext_vector_type(2)));
    bf16x8 At[4][2], B0[2][2], B1[2][2];
    const char* cA = (const char*)g.A + (size_t)cur.pm * tstep; const char* cB = (const char*)g.Bt + (size_t)cur.pn * tstep;
    S.a_ready(cur);
    if constexpr (SP2) {
        PG8_STAGE(PG8_SB(0, 0), cB, voffB); PG8_STAGE(PG8_SB(0, 1), cB + hstep, voffB); PG8_STAGE(PG8_SA(0, 0), cA, voffA); PG8_STAGE(PG8_SA(0, 1), cA + hstep, voffA);
        if (wr == 1) PG8_BAR;
        PG8_WAIT_V(2); PG8_BAR;
        PG8_STAGE(PG8_SB(1, 0), cB + kstep, voffB); PG8_STAGE(PG8_SA(1, 0), cA + kstep, voffA); PG8_STAGE(PG8_SB(1, 1), cB + hstep + kstep, voffB);
        PG8_WAIT_V(6); PG8_BAR;
    } else {
        PG8_STAGE(PG8_SB(0, 0), cB, voffB); PG8_STAGE(PG8_SA(0, 0), cA, voffA); PG8_STAGE(PG8_SB(0, 1), cB + hstep, voffB); PG8_STAGE(PG8_SA(0, 1), cA + hstep, voffA);
        if (wr == 1) PG8_BAR;
        PG8_WAIT_V(4); PG8_BAR;
        PG8_STAGE(PG8_SB(1, 0), cB + kstep, voffB); PG8_STAGE(PG8_SA(1, 0), cA + kstep, voffA); PG8_STAGE(PG8_SB(1, 1), cB + hstep + kstep, voffB);
        PG8_WAIT_V(6); PG8_BAR;
    }
    for (;;) {
        const bool has_next = S.next(ui + 1, nxt);
        const char* nA = has_next ? (const char*)g.A + (size_t)nxt.pm * tstep : cA; const char* nB = has_next ? (const char*)g.Bt + (size_t)nxt.pn * tstep : cB;
        for (int t = 0; t < nt; t += 2) {
            const bool last = (t == nt - 2);
            const char* a1 = cA + (size_t)(t + 1) * kstep;
            const char* a2 = last ? nA : cA + (size_t)(t + 2) * kstep; const char* b2 = last ? nB : cB + (size_t)(t + 2) * kstep;
            const char* a3 = a2 + kstep; const char* b3 = b2 + kstep;
            if (last && has_next) S.a_ready(nxt);
            if constexpr (SP2) {
            PG8_LDB(B0, 0, 0); PG8_LDB(B1, 0, 1); PG8_SCHED; PG8_LDA(At, 0, 0); PG8_STAGE(PG8_SA(1, 1), a1 + hstep, voffA);
            PG8_WAIT_V(8); PG8_WAIT_L(0); PG8_BAR; PG8_MMA(0, 0, At, B0); PG8_MMA(0, 1, At, B1); PG8_BAR; PG8_SCHED;
            PG8_LDA(At, 0, 1); PG8_STAGE(PG8_SB(0, 0), b2, voffB); PG8_STAGE(PG8_SB(0, 1), b2 + hstep, voffB); PG8_STAGE(PG8_SA(0, 0), a2, voffA);
            PG8_WAIT_V(8); PG8_WAIT_L(0); PG8_BAR; PG8_MMA(1, 0, At, B0); PG8_MMA(1, 1, At, B1); PG8_BAR; PG8_SCHED;
            PG8_LDB(B0, 1, 0); PG8_LDB(B1, 1, 1); PG8_SCHED; PG8_LDA(At, 1, 0); PG8_STAGE(PG8_SA(0, 1), a2 + hstep, voffA);
            PG8_WAIT_V(8); PG8_WAIT_L(0); PG8_BAR; PG8_MMA(0, 0, At, B0); PG8_MMA(0, 1, At, B1); PG8_BAR; PG8_SCHED;
            PG8_LDA(At, 1, 1); PG8_STAGE(PG8_SB(1, 0), b3, voffB); PG8_STAGE(PG8_SB(1, 1), b3 + hstep, voffB); PG8_STAGE(PG8_SA(1, 0), a3, voffA);
            PG8_WAIT_V(8); PG8_WAIT_L(0); PG8_BAR; PG8_MMA(1, 0, At, B0); PG8_MMA(1, 1, At, B1); PG8_BAR; PG8_SCHED;
            } else {
            PG8_LDB(B0, 0, 0); PG8_SCHED; PG8_LDA(At, 0, 0); PG8_STAGE(PG8_SA(1, 1), a1 + hstep, voffA);
            PG8_WAIT_L(8); PG8_BAR; PG8_WAIT_L(0); PG8_MMA(0, 0, At, B0); PG8_BAR; PG8_SCHED;
            PG8_LDB(B1, 0, 1); PG8_STAGE(PG8_SB(0, 0), b2, voffB);
            PG8_BAR; PG8_WAIT_L(0); PG8_MMA(0, 1, At, B1); PG8_BAR;
            PG8_LDA(At, 0, 1); PG8_STAGE(PG8_SA(0, 0), a2, voffA);
            PG8_BAR; PG8_WAIT_L(0); PG8_MMA(1, 0, At, B0); PG8_BAR; PG8_SCHED;
            PG8_STAGE(PG8_SB(0, 1), b2 + hstep, voffB);
            PG8_WAIT_V(6); PG8_BAR; PG8_MMA(1, 1, At, B1); PG8_BAR;
            PG8_LDB(B0, 1, 0); PG8_SCHED; PG8_LDA(At, 1, 0); PG8_STAGE(PG8_SA(0, 1), a2 + hstep, voffA);
            PG8_WAIT_L(8); PG8_BAR; PG8_WAIT_L(0); PG8_MMA(0, 0, At, B0); PG8_BAR; PG8_SCHED;
            PG8_LDB(B1, 1, 1); PG8_STAGE(PG8_SB(1, 0), b3, voffB);
            PG8_BAR; PG8_WAIT_L(0); PG8_MMA(0, 1, At, B1); PG8_BAR;
            PG8_LDA(At, 1, 1); PG8_STAGE(PG8_SA(1, 0), a3, voffA);
            PG8_BAR; PG8_WAIT_L(0); PG8_MMA(1, 0, At, B0); PG8_BAR; PG8_SCHED;
            PG8_STAGE(PG8_SB(1, 1), b3 + hstep, voffB);
            PG8_WAIT_V(6); PG8_BAR; PG8_MMA(1, 1, At, B1); PG8_BAR;
            }
        }
        if constexpr (ALIGN_EPI) { if (wr == 0) PG8_BAR; }
        if constexpr (!Epi::AFTER_DRAIN) { E(acc, cur, wr, wc, fr, fq); S.done(cur); }
        if (!has_next) break;
        { float z_ = 0.f; asm volatile("" : "+v"(z_));
#pragma unroll
        for (int a = 0; a < 2; ++a)
#pragma unroll
            for (int b = 0; b < 2; ++b)
#pragma unroll
                for (int m = 0; m < 4; ++m)
#pragma unroll
                    for (int n = 0; n < 2; ++n) acc[a][b][m][n] = (f32x4){z_, z_, z_, z_}; }
        cur = nxt; cA = nA; cB = nB; ++ui;
        if constexpr (ALIGN_EPI) { if (wr == 1) PG8_BAR; }
    }
    PG8_WAIT_V(0);
    if constexpr (!ALIGN_EPI) { if (wr == 0) PG8_BAR; }
    PG8_BAR;
    if constexpr (Epi::AFTER_DRAIN) { E.fused(acc, cur, wr, wc, fr, fq, lds, wid, lane); S.done(cur); }
#undef PG8_SA
#undef PG8_SB
#undef PG8_STAGE
#undef PG8_LDA
#undef PG8_LDB
#undef PG8_MMA
#undef PG8_WAIT_V
#undef PG8_WAIT_L
#undef PG8_BAR
#undef PG8_SCHED
}
}
namespace mk {
#ifndef MK_FP8_INPROJ
#define MK_FP8_INPROJ 1
#endif
constexpr int D = 2048, NB = 2, S = 8192, T = NB * S, DEPTH = 4;
constexpr float ALPHA = 1.681792830507429f, LN_EPS = 1e-5f;
constexpr int NWAVES = 8, NTHREADS = 512;

#define GAS __attribute__((address_space(1)))
#define LAS __attribute__((address_space(3)))
typedef unsigned short bf16;
typedef unsigned v4u __attribute__((ext_vector_type(4)));
typedef unsigned v2u __attribute__((ext_vector_type(2)));
typedef float f32x4 __attribute__((ext_vector_type(4)));
typedef float f32x2 __attribute__((ext_vector_type(2)));
typedef short bf16x8 __attribute__((ext_vector_type(8)));
#define LDS_WAIT() asm volatile("s_waitcnt lgkmcnt(0)" ::: "memory")
#define VM_WAIT() asm volatile("s_waitcnt vmcnt(0)" ::: "memory")

constexpr size_t MiB = 1u << 20;
constexpr size_t WS_CTL = 0, CTL_ZERO_BYTES = 384 * 1024;
constexpr size_t WS_WIN = 1 * MiB;
constexpr size_t WS_WOUT = WS_WIN + 96 * MiB;
constexpr size_t WS_WQG = WS_WOUT + 32 * MiB;
constexpr size_t WS_WPJ = WS_WQG + 64 * MiB;
constexpr size_t WS_WGT = WS_WPJ + 4 * MiB;
constexpr size_t WS_WGB = WS_WGT + 512 * 1024;
constexpr size_t WS_UB = WS_WGT + 1 * MiB;
constexpr size_t WS_VB = WS_UB + 256 * MiB;
constexpr size_t WS_OG = WS_VB;
constexpr size_t WS_LSE = WS_VB + 96 * MiB;
constexpr size_t WS_CS = WS_VB + 104 * MiB;
constexpr size_t WS_SKB = WS_VB + 98 * MiB;
constexpr size_t WS_PB = WS_VB + 256 * MiB;
constexpr size_t WS_XF = WS_PB + 32 * MiB;
constexpr size_t WS_XB = WS_XF + 128 * MiB;
constexpr size_t WS_HB = WS_XB + 64 * MiB;
constexpr size_t WS_YB = WS_HB + 192 * MiB;
constexpr size_t WS_ZF = WS_YB + 64 * MiB;
constexpr size_t WS_X1F = WS_ZF + 128 * MiB;
constexpr size_t WS_PST = WS_X1F;
constexpr size_t WS_PC = WS_X1F + 4 * MiB;
constexpr size_t WS_X8 = WS_X1F + 16 * MiB;
constexpr size_t WS_SX = WS_X1F + 12 * MiB;
constexpr size_t WS_SW = WS_X1F + 13 * MiB;
constexpr size_t WS_Z8 = WS_X1F + 128 * MiB;
constexpr size_t WS_RS = WS_X1F + 14 * MiB;
constexpr size_t WS_SWQ = WS_X1F + 15 * MiB;
constexpr size_t WS_CMQ = 256 * 1024;
constexpr size_t WS_Y8 = WS_Z8 + 32 * MiB;
constexpr size_t WS_SY = WS_X1F + 14 * MiB + 512 * 1024;
constexpr size_t WS_SWO = WS_X1F + 15 * MiB + 512 * 1024;
constexpr size_t WS_CMO = 320 * 1024;
constexpr size_t WS_XQ = WS_X1F + 48 * MiB;
constexpr size_t WS_R4 = WS_X1F + 80 * MiB;
constexpr size_t WS_CM = 128 * 1024;
constexpr size_t WS_C12 = WS_X1F + 8 * MiB;
constexpr size_t WS_X1B = WS_X1F + 128 * MiB;
constexpr size_t WS_QB = WS_X1B + 64 * MiB;
constexpr size_t WS_PJ = WS_QB + 64 * MiB;
constexpr size_t WS_PLE = WS_PJ + 64 * MiB;
constexpr size_t WS_IDX = WS_PLE + 64 * MiB;
constexpr size_t WS_GW = WS_IDX + 8 * MiB;
constexpr size_t WS_CL = WS_GW + 8 * MiB;
constexpr size_t WS_ML = WS_CL + 128 * MiB;
constexpr size_t WS_GA = WS_ML + 2 * MiB;
constexpr size_t WS_END = WS_GA + 1 * MiB;
static_assert(WS_END <= (size_t)2040 * MiB, "workspace map");
constexpr int CW_BAR = 4096, CW_GSYNC = 16384;

constexpr int RING_OFF = 0, RING_BYTES = 143360;
constexpr int LDSCTL_OFF = RING_BYTES, MISC_OFF = LDSCTL_OFF + 320;
constexpr int STAT_OFF = 145408;
constexpr int LDS_BYTES = 145408 + 8192;

__device__ __forceinline__ unsigned f2bf(float f) { unsigned u = __builtin_bit_cast(unsigned, f); return (u + 0x7fffu + ((u >> 16) & 1u)) >> 16; }
__device__ __forceinline__ unsigned pk2(float lo, float hi) { return __builtin_amdgcn_perm(__builtin_bit_cast(unsigned, hi) + 0x8000u, __builtin_bit_cast(unsigned, lo) + 0x8000u, 0x07060302u); }
__device__ __forceinline__ float bflo(unsigned w) { return __builtin_bit_cast(float, w << 16); }
__device__ __forceinline__ float bfhi(unsigned w) { return __builtin_bit_cast(float, w & 0xffff0000u); }
__device__ __forceinline__ float bf2f(bf16 h) { return __builtin_bit_cast(float, (unsigned)h << 16); }
__device__ __forceinline__ int ov(int x) { asm volatile("" : "+v"(x)); return x; }
template <int CTRL> __device__ __forceinline__ unsigned dpp_u(unsigned v) { return (unsigned)__builtin_amdgcn_update_dpp((int)v, (int)v, CTRL, 0xF, 0xF, true); }
template <int M> __device__ __forceinline__ unsigned xlane_u(unsigned v, int lane) {
    if constexpr (M == 1) return dpp_u<0xB1>(v);
    else if constexpr (M == 2) return dpp_u<0x4E>(v);
    else if constexpr (M == 4) return dpp_u<0x1B>(dpp_u<0x141>(v));
    else if constexpr (M == 8) return dpp_u<0x128>(v);
    else if constexpr (M == 16) { auto r = __builtin_amdgcn_permlane16_swap(v, v, false, false); return (lane & 16) ? r[0] : r[1]; }
    else { auto r = __builtin_amdgcn_permlane32_swap(v, v, false, false); return (lane & 32) ? r[0] : r[1]; }
}
template <int M> __device__ __forceinline__ float xlane(float v, int lane) { return __uint_as_float(xlane_u<M>(__float_as_uint(v), lane)); }
__device__ __forceinline__ float xrow_sum(float v) {
    { auto r = __builtin_amdgcn_permlane16_swap(__float_as_uint(v), __float_as_uint(v), false, false); v = __uint_as_float(r[0]) + __uint_as_float(r[1]); }
    { auto r = __builtin_amdgcn_permlane32_swap(__float_as_uint(v), __float_as_uint(v), false, false); v = __uint_as_float(r[0]) + __uint_as_float(r[1]); }
    return v;
}
__device__ __forceinline__ float xrow_max(float v) {
    { auto r = __builtin_amdgcn_permlane16_swap(__float_as_uint(v), __float_as_uint(v), false, false); v = fmaxf(__uint_as_float(r[0]), __uint_as_float(r[1])); }
    { auto r = __builtin_amdgcn_permlane32_swap(__float_as_uint(v), __float_as_uint(v), false, false); v = fmaxf(__uint_as_float(r[0]), __uint_as_float(r[1])); }
    return v;
}
__device__ __forceinline__ int fresh_lane() { unsigned z = 0u; asm volatile("" : "+v"(z)); return (int)__builtin_amdgcn_mbcnt_hi(~0u, __builtin_amdgcn_mbcnt_lo(~0u, z)); }
__device__ __forceinline__ int shx_i(int v, int m, int lane) { return __builtin_amdgcn_ds_bpermute((lane ^ m) << 2, v); }
__device__ __forceinline__ float shx(float v, int m, int lane) { return __builtin_bit_cast(float, shx_i(__builtin_bit_cast(int, v), m, lane)); }
__device__ __forceinline__ int shl_i(int v, int from_lane) { return __builtin_amdgcn_ds_bpermute(from_lane << 2, v); }
__device__ __forceinline__ float wave_sum(float v) {
    const int l_ = fresh_lane();
#pragma unroll
    for (int o = 32; o >= 1; o >>= 1) v += shx(v, o, l_);
    return v;
}
__device__ __forceinline__ float wave_max(float v) {
    const int l_ = fresh_lane();
#pragma unroll
    for (int o = 32; o >= 1; o >>= 1) v = fmaxf(v, shx(v, o, l_));
    return v;
}
__device__ __forceinline__ float sigmoidf_(float x) { return 1.0f / (1.0f + __expf(-x)); }
__device__ __forceinline__ float logsig(float x) { return fminf(x, 0.f) - __logf(1.0f + __expf(-fabsf(x))); }
__device__ __forceinline__ float ln_rstd(float q) { return __builtin_amdgcn_rsqf((q + LN_EPS * (float)D) * (1.0f / D)); }

#define XB_TMO      128
#define XB_XCNT(j)  (256  + 64 * (j))
#define XB_XSUB(j)  (1280 + 64 * (j))
#define XB_XGEN(j)  (2304 + 64 * (j))
#define XB_TOP      3328
#define XB_TOPGEN   3392
#define XCD_BAR_WORDS 3456
#define XB_SPIN_CAP (1u << 22)

__device__ __forceinline__ unsigned xb_ld(unsigned* p)              { return __hip_atomic_load(p, __ATOMIC_RELAXED, __HIP_MEMORY_SCOPE_AGENT); }
__device__ __forceinline__ unsigned xb_add(unsigned* p, unsigned v) { return __hip_atomic_fetch_add(p, v, __ATOMIC_RELAXED, __HIP_MEMORY_SCOPE_AGENT); }
__device__ __forceinline__ unsigned xb_xcc_id() { return (unsigned)__builtin_amdgcn_s_getreg((3 << 11) | 20) & 0xFu; }
#define XB_SPIN(cond, bar) do { unsigned _sp = 0; while (cond) { __builtin_amdgcn_s_sleep(1); \
    if ((++_sp & 255u) == 0u) { if (xb_ld(&(bar)[XB_TMO])) break; if (_sp > XB_SPIN_CAP) { atomicAdd(&(bar)[XB_TMO], 1u); break; } } } } while (0)

struct XcdBarrier { unsigned* bar; unsigned x; volatile LAS unsigned* st; };

__device__ __forceinline__ XcdBarrier xcd_barrier_post(unsigned* bar, volatile LAS unsigned* st) {
    XcdBarrier b; b.bar = bar; b.x = xb_xcc_id(); b.st = st;
    if (threadIdx.x == 0) (void)xb_add(&bar[XB_XCNT(b.x)], 1u);
    return b;
}
__device__ __forceinline__ void xcd_barrier_complete(unsigned* bar, unsigned x, unsigned& nloc, unsigned& nx) {
    const unsigned G = gridDim.x * gridDim.y * gridDim.z;
    unsigned sum, cnt, mine, sp = 0u;
    for (;;) {
        sum = 0u; cnt = 0u; mine = 0u;
#pragma unroll 1
        for (unsigned j = 0; j < 16; ++j) { const unsigned c = xb_ld(&bar[XB_XCNT(j)]); sum += c; cnt += (c > 0u) ? 1u : 0u; mine = (j == x) ? c : mine; }
        if (sum == G) break;
        __builtin_amdgcn_s_sleep(1);
        if ((++sp & 255u) == 0u) { if (xb_ld(&bar[XB_TMO])) break; if (sp > XB_SPIN_CAP) { atomicAdd(&bar[XB_TMO], 1u); break; } }
    }
    nloc = mine > 0u ? mine : 1u; nx = cnt > 0u ? cnt : 1u;
}
__device__ __forceinline__ void xcd_barrier(const XcdBarrier& b, const bool leader) {
    asm volatile("s_waitcnt vmcnt(0)" ::: "memory");
    __syncthreads();
    if (leader) {
        unsigned* bar = b.bar; asm volatile("" : "+s"(bar));
        unsigned bx = b.x; asm volatile("" : "+s"(bx));
        __builtin_amdgcn_s_waitcnt(0);
        unsigned nloc = b.st[0], nx = b.st[1];
        if (nloc == 0u) { xcd_barrier_complete(bar, bx, nloc, nx); b.st[0] = nloc; b.st[1] = nx; }
        const unsigned old = xb_add(&bar[XB_XSUB(bx)], 1u);
        const unsigned gen = old / nloc;
        if (old + 1u == (gen + 1u) * nloc) {
            __builtin_amdgcn_fence(__ATOMIC_RELEASE, "agent");
            asm volatile("s_waitcnt vmcnt(0)" ::: "memory");
            const unsigned og = xb_add(&bar[XB_TOP], 1u);
            const unsigned tg = og / nx;
            if (og + 1u == (tg + 1u) * nx) xb_add(&bar[XB_TOPGEN], 1u);
            else XB_SPIN(xb_ld(&bar[XB_TOPGEN]) == tg, bar);
            __builtin_amdgcn_fence(__ATOMIC_ACQUIRE, "agent");
            xb_add(&bar[XB_XGEN(bx)], 1u);
            asm volatile("s_waitcnt vmcnt(0)" ::: "memory");
        } else {
            XB_SPIN(xb_ld(&bar[XB_XGEN(bx)]) == gen, bar);
            __builtin_amdgcn_fence(__ATOMIC_ACQUIRE, "agent");
            asm volatile("s_waitcnt vmcnt(0)" ::: "memory");
        }
    }
    __syncthreads();
}

struct EpiPlain {
    static constexpr bool PERM = true, AFTER_DRAIN = false;
    bf16* O; int ldc;
    __device__ __forceinline__ void operator()(const pg8::f32x4 (&acc)[2][2][4][2], const pg8::Unit& u, int wr, int wc, int fr_, int fq_) const {
        const int el_ = fresh_lane(), fr = el_ & 15, fq = el_ >> 4; (void)fr_; (void)fq_;
        const int row0 = u.pm * 256 + wr * 64 + fr, col0 = u.pn * 256 + wc * 32 + 8 * fq;
        const __amdgpu_buffer_rsrc_t rs = __builtin_amdgcn_make_buffer_rsrc((void*)O, (short)0, (int)((size_t)T * ldc * 2), 0x00020000);
#pragma unroll
        for (int ai = 0; ai < 2; ++ai)
#pragma unroll
            for (int m = 0; m < 4; ++m) { const unsigned ro = (unsigned)(((size_t)(row0 + ai * 128 + m * 16) * ldc + col0) * 2);
#pragma unroll
                for (int bj = 0; bj < 2; ++bj) { const pg8::f32x4 v0 = acc[ai][bj][m][0], v1 = acc[ai][bj][m][1];
                    v4u w; w.x = pg8::cvt_pk_bf16(v0[0], v0[1]); w.y = pg8::cvt_pk_bf16(v0[2], v0[3]); w.z = pg8::cvt_pk_bf16(v1[0], v1[1]); w.w = pg8::cvt_pk_bf16(v1[2], v1[3]);
                    __builtin_amdgcn_raw_buffer_store_b128(w, rs, ro + bj * 256, 0, 16); } }
    }
};
struct EpiPlainI8 {
    static constexpr bool PERM = true, AFTER_DRAIN = false;
    bf16* O; int ldc; const float* SX; const float* SW;
    __device__ __forceinline__ void operator()(const pg8::f32x4 (&acc)[2][2][4][2], const pg8::Unit& u, int wr, int wc, int fr_, int fq_) const {
        const int el_ = fresh_lane(), fr = el_ & 15, fq = el_ >> 4; (void)fr_; (void)fq_;
        const int row0 = u.pm * 256 + wr * 64 + fr, col0 = u.pn * 256 + wc * 32 + 8 * fq;
        const __amdgpu_buffer_rsrc_t rs = __builtin_amdgcn_make_buffer_rsrc((void*)O, (short)0, (int)((size_t)T * ldc * 2), 0x00020000);
        float sxv[8];
#pragma unroll
        for (int r8 = 0; r8 < 8; ++r8) sxv[r8] = SX[row0 + (r8 >> 2) * 128 + (r8 & 3) * 16];
#pragma unroll
        for (int bj = 0; bj < 2; ++bj) {
            const pg8::f32x4 s0 = *(const pg8::f32x4*)(SW + col0 + bj * 128), s1 = *(const pg8::f32x4*)(SW + col0 + bj * 128 + 4);
#pragma unroll
            for (int ai = 0; ai < 2; ++ai)
#pragma unroll
                for (int m = 0; m < 4; ++m) { const int row = row0 + ai * 128 + m * 16; const float sx = sxv[ai * 4 + m];
                    const unsigned ro = (unsigned)(((size_t)row * ldc + col0) * 2);
                    const pg8::f32x4 a0 = acc[ai][bj][m][0], a1 = acc[ai][bj][m][1];
                    typedef int i32x4_ __attribute__((ext_vector_type(4)));
                    const pg8::f32x4 f0 = __builtin_convertvector(__builtin_bit_cast(i32x4_, a0), pg8::f32x4) * (s0 * sx), f1 = __builtin_convertvector(__builtin_bit_cast(i32x4_, a1), pg8::f32x4) * (s1 * sx);
                    const float v[8] = {f0[0], f0[1], f0[2], f0[3], f1[0], f1[1], f1[2], f1[3]};
                    v4u w; w.x = pg8::cvt_pk_bf16(v[0], v[1]); w.y = pg8::cvt_pk_bf16(v[2], v[3]); w.z = pg8::cvt_pk_bf16(v[4], v[5]); w.w = pg8::cvt_pk_bf16(v[6], v[7]);
                    __builtin_amdgcn_raw_buffer_store_b128(w, rs, ro + bj * 256, 0, 0); }
        }
    }
};
struct EpiZ {
    static constexpr bool PERM = true, AFTER_DRAIN = false;
    bf16* Z; const float* XF; const bf16* XBh;
    float* PST;
    __device__ __forceinline__ void operator()(const pg8::f32x4 (&acc)[2][2][4][2], const pg8::Unit& u, int wr, int wc, int fr_, int fq_) const {
        const int el_ = fresh_lane(), fr = el_ & 15, fq = el_ >> 4; (void)fr_; (void)fq_;
        const int row0 = u.pm * 256 + wr * 64 + fr, col0 = u.pn * 256 + wc * 32 + 8 * fq;
#pragma unroll
        for (int ai = 0; ai < 2; ++ai)
#pragma unroll
            for (int m = 0; m < 4; ++m) { const size_t ro = (size_t)(row0 + ai * 128 + m * 16) * D + col0;
                float s = 0.f, ss = 0.f;
#pragma unroll
                for (int bj = 0; bj < 2; ++bj) {
                    pg8::f32x4 x0, x1;
                    if (XF) { x0 = *(const pg8::f32x4*)(XF + ro + bj * 128); x1 = *(const pg8::f32x4*)(XF + ro + bj * 128 + 4); }
                    else { const v4u xw = *(const v4u*)(XBh + ro + bj * 128); x0 = (pg8::f32x4){bflo(xw.x), bfhi(xw.x), bflo(xw.y), bfhi(xw.y)}; x1 = (pg8::f32x4){bflo(xw.z), bfhi(xw.z), bflo(xw.w), bfhi(xw.w)}; }
                    const pg8::f32x4 v0 = acc[ai][bj][m][0] + x0 * ALPHA, v1 = acc[ai][bj][m][1] + x1 * ALPHA;
                    s += ((v0[0] + v0[1]) + (v0[2] + v0[3])) + ((v1[0] + v1[1]) + (v1[2] + v1[3]));
                    ss += ((v0[0] * v0[0] + v0[1] * v0[1]) + (v0[2] * v0[2] + v0[3] * v0[3])) + ((v1[0] * v1[0] + v1[1] * v1[1]) + (v1[2] * v1[2] + v1[3] * v1[3]));
                    v4u w; w.x = pg8::cvt_pk_bf16(v0[0], v0[1]); w.y = pg8::cvt_pk_bf16(v0[2], v0[3]); w.z = pg8::cvt_pk_bf16(v1[0], v1[1]); w.w = pg8::cvt_pk_bf16(v1[2], v1[3]);
                    *(v4u*)(Z + ro + bj * 128) = w; asm volatile("" ::: "memory"); }
                s = xrow_sum(s); ss = xrow_sum(ss);
                if (fq == 0) *(f32x2*)(PST + ((size_t)(row0 + ai * 128 + m * 16) * 32 + u.pn * 4 + wc) * 2) = (f32x2){s, ss}; }
    }
};
struct EpiQG {
    static constexpr bool PERM = true, AFTER_DRAIN = false;
    bf16* QB; const bf16* PJ; bf16* PLE; const float* C12; LAS const float* ST; int pm0, pm1, pm2;
    __device__ __forceinline__ void operator()(const pg8::f32x4 (&acc)[2][2][4][2], const pg8::Unit& u, int wr, int wc, int fr_, int fq_) const {
        const int el_ = fresh_lane(), fr = el_ & 15, fq = el_ >> 4; (void)fr_; (void)fq_;
        const int row0 = u.pm * 256 + wr * 64 + fr;
        const int slot = (u.pm == pm0) ? 0 : (u.pm == pm1) ? 1 : (u.pm == pm2) ? 2 : 3;
        float rs_[8], mr_[8];
#pragma unroll
        for (int ai = 0; ai < 2; ++ai)
#pragma unroll
            for (int m = 0; m < 4; ++m) { const f32x2 st = *(LAS const f32x2*)(ST + (slot * 256 + wr * 64 + fr + ai * 128 + m * 16) * 2); rs_[ai * 4 + m] = st.x; mr_[ai * 4 + m] = st.y; }
        const bool isq = u.pn < 8;
        bf16* const OUTP = QB + (isq ? (size_t)0 : (size_t)((WS_PLE - WS_QB) / 2));
        const int col0 = (isq ? u.pn : u.pn - 8) * 256 + wc * 32 + 8 * fq, ncol = u.pn * 256 + wc * 32 + 8 * fq;
#pragma unroll
        for (int bj = 0; bj < 2; ++bj) {
            const pg8::f32x4* cp = (const pg8::f32x4*)(C12 + (size_t)(ncol + bj * 128) * 2);
            const pg8::f32x4 k0 = cp[0], k1 = cp[1], k2 = cp[2], k3 = cp[3];
#pragma unroll
            for (int ai = 0; ai < 2; ++ai)
#pragma unroll
                for (int m = 0; m < 4; ++m) { const size_t ro = (size_t)(row0 + ai * 128 + m * 16) * D + col0 + bj * 128;
                    const float rstd = rs_[ai * 4 + m], mr = mr_[ai * 4 + m];
                    pg8::f32x4 v0 = acc[ai][bj][m][0], v1 = acc[ai][bj][m][1];
                    v0[0] = v0[0] * rstd + (mr * k0[0] + k0[1]); v0[1] = v0[1] * rstd + (mr * k0[2] + k0[3]); v0[2] = v0[2] * rstd + (mr * k1[0] + k1[1]); v0[3] = v0[3] * rstd + (mr * k1[2] + k1[3]);
                    v1[0] = v1[0] * rstd + (mr * k2[0] + k2[1]); v1[1] = v1[1] * rstd + (mr * k2[2] + k2[3]); v1[2] = v1[2] * rstd + (mr * k3[0] + k3[1]); v1[3] = v1[3] * rstd + (mr * k3[2] + k3[3]);
                    if (!isq) { const v4u pj = *(const v4u*)(PJ + ro);
                        v0[0] = sigmoidf_(v0[0]) * bflo(pj.x); v0[1] = sigmoidf_(v0[1]) * bfhi(pj.x); v0[2] = sigmoidf_(v0[2]) * bflo(pj.y); v0[3] = sigmoidf_(v0[3]) * bfhi(pj.y);
                        v1[0] = sigmoidf_(v1[0]) * bflo(pj.z); v1[1] = sigmoidf_(v1[1]) * bfhi(pj.z); v1[2] = sigmoidf_(v1[2]) * bflo(pj.w); v1[3] = sigmoidf_(v1[3]) * bfhi(pj.w); }
                    v4u w; w.x = pg8::cvt_pk_bf16(v0[0], v0[1]); w.y = pg8::cvt_pk_bf16(v0[2], v0[3]); w.z = pg8::cvt_pk_bf16(v1[0], v1[1]); w.w = pg8::cvt_pk_bf16(v1[2], v1[3]);
                    *(v4u*)(OUTP + ro) = w; asm volatile("" ::: "memory"); }
        }
    }
};

struct EpiZ8 {
    static constexpr bool PERM = true, AFTER_DRAIN = false;
    bf16* Z; const float* XF; const bf16* XBh; const float* SY; const float* SWO;
    __device__ __forceinline__ void operator()(const pg8::f32x4 (&acc)[2][2][4][2], const pg8::Unit& u, int wr, int wc, int fr_, int fq_) const {
        typedef int i32x4_ __attribute__((ext_vector_type(4)));
        const int el_ = fresh_lane(), fr = el_ & 15, fq = el_ >> 4; (void)fr_; (void)fq_;
        const int row0 = u.pm * 256 + wr * 64 + fr, col0 = u.pn * 256 + wc * 32 + 8 * fq;
        float syv[8];
#pragma unroll
        for (int r8 = 0; r8 < 8; ++r8) syv[r8] = SY[row0 + (r8 >> 2) * 128 + (r8 & 3) * 16];
#pragma unroll
        for (int bj = 0; bj < 2; ++bj) {
            const pg8::f32x4 w0 = *(const pg8::f32x4*)(SWO + col0 + bj * 128), w1 = *(const pg8::f32x4*)(SWO + col0 + bj * 128 + 4);
#pragma unroll
            for (int ai = 0; ai < 2; ++ai)
#pragma unroll
                for (int m = 0; m < 4; ++m) { const int row = row0 + ai * 128 + m * 16; const size_t ro = (size_t)row * D + col0 + bj * 128; const float sy = syv[ai * 4 + m];
                    pg8::f32x4 x0, x1;
                    if (XF) { x0 = *(const pg8::f32x4*)(XF + ro); x1 = *(const pg8::f32x4*)(XF + ro + 4); }
                    else { const v4u xw = *(const v4u*)(XBh + ro); x0 = (pg8::f32x4){bflo(xw.x), bfhi(xw.x), bflo(xw.y), bfhi(xw.y)}; x1 = (pg8::f32x4){bflo(xw.z), bfhi(xw.z), bflo(xw.w), bfhi(xw.w)}; }
                    const pg8::f32x4 v0 = __builtin_convertvector(__builtin_bit_cast(i32x4_, acc[ai][bj][m][0]), pg8::f32x4) * (w0 * sy) + x0 * ALPHA;
                    const pg8::f32x4 v1 = __builtin_convertvector(__builtin_bit_cast(i32x4_, acc[ai][bj][m][1]), pg8::f32x4) * (w1 * sy) + x1 * ALPHA;
                    v4u w; w.x = pg8::cvt_pk_bf16(v0[0], v0[1]); w.y = pg8::cvt_pk_bf16(v0[2], v0[3]); w.z = pg8::cvt_pk_bf16(v1[0], v1[1]); w.w = pg8::cvt_pk_bf16(v1[2], v1[3]);
                    *(v4u*)(Z + ro) = w; asm volatile("" ::: "memory"); }
        }
    }
};
struct EpiQG8 {
    static constexpr bool PERM = true, AFTER_DRAIN = false;
    bf16* QB; const bf16* PJ; bf16* PLE; const float* C12; const float* RS; const float* SWQ;
    __device__ __forceinline__ void operator()(const pg8::f32x4 (&acc)[2][2][4][2], const pg8::Unit& u, int wr, int wc, int fr_, int fq_) const {
        typedef int i32x4_ __attribute__((ext_vector_type(4)));
        const int el_ = fresh_lane(), fr = el_ & 15, fq = el_ >> 4; (void)fr_; (void)fq_;
        const int row0 = u.pm * 256 + wr * 64 + fr;
        f32x2 rsv[8];
#pragma unroll
        for (int ai = 0; ai < 2; ++ai)
#pragma unroll
            for (int m = 0; m < 4; ++m) rsv[ai * 4 + m] = *(const f32x2*)(RS + (size_t)(row0 + ai * 128 + m * 16) * 2);
        const bool isq = u.pn < 8;
        bf16* const OUTP = QB + (isq ? (size_t)0 : (size_t)((WS_PLE - WS_QB) / 2));
        const int col0 = (isq ? u.pn : u.pn - 8) * 256 + wc * 32 + 8 * fq, ncol = u.pn * 256 + wc * 32 + 8 * fq;
#pragma unroll
        for (int bj = 0; bj < 2; ++bj) {
            const pg8::f32x4* cp = (const pg8::f32x4*)(C12 + (size_t)(ncol + bj * 128) * 2);
            const pg8::f32x4 k0 = cp[0], k1 = cp[1], k2 = cp[2], k3 = cp[3];
            const pg8::f32x4 w0 = *(const pg8::f32x4*)(SWQ + ncol + bj * 128), w1 = *(const pg8::f32x4*)(SWQ + ncol + bj * 128 + 4);
#pragma unroll
            for (int ai = 0; ai < 2; ++ai)
#pragma unroll
                for (int m = 0; m < 4; ++m) { const size_t ro = (size_t)(row0 + ai * 128 + m * 16) * D + col0 + bj * 128;
                    const float rz = rsv[ai * 4 + m].x, mr = rsv[ai * 4 + m].y;
                    pg8::f32x4 v0 = __builtin_convertvector(__builtin_bit_cast(i32x4_, acc[ai][bj][m][0]), pg8::f32x4) * (w0 * rz);
                    pg8::f32x4 v1 = __builtin_convertvector(__builtin_bit_cast(i32x4_, acc[ai][bj][m][1]), pg8::f32x4) * (w1 * rz);
                    v0[0] += mr * k0[0] + k0[1]; v0[1] += mr * k0[2] + k0[3]; v0[2] += mr * k1[0] + k1[1]; v0[3] += mr * k1[2] + k1[3];
                    v1[0] += mr * k2[0] + k2[1]; v1[1] += mr * k2[2] + k2[3]; v1[2] += mr * k3[0] + k3[1]; v1[3] += mr * k3[2] + k3[3];
                    if (!isq) { const v4u pj = *(const v4u*)(PJ + ro);
                        v0[0] = sigmoidf_(v0[0]) * bflo(pj.x); v0[1] = sigmoidf_(v0[1]) * bfhi(pj.x); v0[2] = sigmoidf_(v0[2]) * bflo(pj.y); v0[3] = sigmoidf_(v0[3]) * bfhi(pj.y);
                        v1[0] = sigmoidf_(v1[0]) * bflo(pj.z); v1[1] = sigmoidf_(v1[1]) * bfhi(pj.z); v1[2] = sigmoidf_(v1[2]) * bflo(pj.w); v1[3] = sigmoidf_(v1[3]) * bfhi(pj.w); }
                    v4u w; w.x = pg8::cvt_pk_bf16(v0[0], v0[1]); w.y = pg8::cvt_pk_bf16(v0[2], v0[3]); w.z = pg8::cvt_pk_bf16(v1[0], v1[1]); w.w = pg8::cvt_pk_bf16(v1[2], v1[3]);
                    *(v4u*)(OUTP + ro) = w; asm volatile("" ::: "memory"); }
        }
    }
};

struct Frame {
    LAS unsigned char* lds;
    int tid, lane, wave, gw, ngw, bid, nwg;
    const float *x, *p; const int* pos;
    const float *even_w_in, *even_conv_w, *even_w_out, *odd_w_in, *odd_gate_bias, *odd_w_out;
    const float *peer_w_q, *peer_sub_keys, *peer_u, *peer_v, *ple_w_proj, *ple_w_gate, *ln_gain, *ln_bias;
    float* out; unsigned char* ws;
};

__device__ __forceinline__ void ln1_row_stats(const Frame& F, const pg8::StaticOrder& So, int& pm0, int& pm1, int& pm2) {
    const float* PST = (const float*)(F.ws + WS_PST);
    LAS float* ST = (LAS float*)(F.lds + STAT_OFF);
    const int tid = F.wave * 64 + fresh_lane(), r = tid >> 1, h = tid & 1;
#pragma unroll
    for (int i = 0; i < 4; ++i) { pg8::Unit u; u.pm = -1; u.pn = 0;
        const bool have = So.next(i, u);
        if (i == 0) pm0 = have ? u.pm : -1; else if (i == 1) pm1 = have ? u.pm : -1; else if (i == 2) pm2 = have ? u.pm : -1;
        if (have) {
            const f32x4* pp = (const f32x4*)(PST + ((size_t)(u.pm * 256 + r) * 32 + h * 16) * 2);
            float s = 0.f, ss = 0.f;
#pragma unroll
            for (int q = 0; q < 8; ++q) { const f32x4 a = pp[q]; s += a[0] + a[2]; ss += a[1] + a[3]; }
            s += xlane<1>(s, 0); ss += xlane<1>(ss, 0);
            const float mean = s * (1.0f / D), var = fmaxf(ss * (1.0f / D) - mean * mean, 0.f), rstd = __builtin_amdgcn_rsqf(var + LN_EPS);
            if (h == 0) *(LAS f32x2*)(ST + (i * 256 + r) * 2) = (f32x2){rstd, -mean * rstd}; } }
    __syncthreads();
}

__device__ __forceinline__ void transpose_item(const float* W, int ldw, int K, bf16* WT, LAS float* scr, int kb, int nb, int lane) {
    const int k0 = 64 * kb, n0 = 32 * nb;
    const int n4 = (lane & 7) * 4, kr = lane >> 3;
#pragma unroll
    for (int i = 0; i < 8; ++i) { const int kk = 8 * i + kr; const f32x4 v = __builtin_nontemporal_load((const f32x4*)(W + (size_t)(k0 + kk) * ldw + n0 + n4));
        scr[kk * 33 + n4] = v[0]; scr[kk * 33 + n4 + 1] = v[1]; scr[kk * 33 + n4 + 2] = v[2]; scr[kk * 33 + n4 + 3] = v[3]; }
    LDS_WAIT();
    const int c = lane & 7;
#pragma unroll
    for (int j = 0; j < 4; ++j) { const int n = (lane >> 3) + 8 * j; const LAS float* s = scr + (8 * c) * 33 + n;
        v4u o; o.x = pk2(s[0 * 33], s[1 * 33]); o.y = pk2(s[2 * 33], s[3 * 33]); o.z = pk2(s[4 * 33], s[5 * 33]); o.w = pk2(s[6 * 33], s[7 * 33]);
        *(v4u*)(WT + (size_t)(n0 + n) * K + k0 + 8 * c) = o; }
    LDS_WAIT();
}
__device__ __forceinline__ void transpose_item_ln(const float* W, int ldw, int K, bf16* WT, LAS float* scr, int kb, int nb, int lane, const float* g, const float* b, float* PC, int ncol0) {
    const int k0 = 64 * kb, n0 = 32 * nb;
    const int n4 = (lane & 7) * 4, kr = lane >> 3;
#pragma unroll
    for (int i = 0; i < 8; ++i) { const int kk = 8 * i + kr; const f32x4 v = __builtin_nontemporal_load((const f32x4*)(W + (size_t)(k0 + kk) * ldw + n0 + n4));
        scr[kk * 33 + n4] = v[0]; scr[kk * 33 + n4 + 1] = v[1]; scr[kk * 33 + n4 + 2] = v[2]; scr[kk * 33 + n4 + 3] = v[3]; }
    LDS_WAIT();
    const int c = lane & 7;
    const f32x4 ga = *(const f32x4*)(g + k0 + 8 * c), gb = *(const f32x4*)(g + k0 + 8 * c + 4), ba = *(const f32x4*)(b + k0 + 8 * c), bb = *(const f32x4*)(b + k0 + 8 * c + 4);
#pragma unroll
    for (int j = 0; j < 4; ++j) { const int n = (lane >> 3) + 8 * j; const LAS float* s = scr + (8 * c) * 33 + n;
        const float w0 = s[0 * 33], w1 = s[1 * 33], w2 = s[2 * 33], w3 = s[3 * 33], w4 = s[4 * 33], w5 = s[5 * 33], w6 = s[6 * 33], w7 = s[7 * 33];
        v4u o; o.x = pk2(w0 * ga[0], w1 * ga[1]); o.y = pk2(w2 * ga[2], w3 * ga[3]); o.z = pk2(w4 * gb[0], w5 * gb[1]); o.w = pk2(w6 * gb[2], w7 * gb[3]);
        *(v4u*)(WT + (size_t)(n0 + n) * K + k0 + 8 * c) = o;
        float c1 = ((bflo(o.x) + bfhi(o.x)) + (bflo(o.y) + bfhi(o.y))) + ((bflo(o.z) + bfhi(o.z)) + (bflo(o.w) + bfhi(o.w)));
        float c2 = ((w0 * ba[0] + w1 * ba[1]) + (w2 * ba[2] + w3 * ba[3])) + ((w4 * bb[0] + w5 * bb[1]) + (w6 * bb[2] + w7 * bb[3]));
        c1 += xlane<1>(c1, 0); c2 += xlane<1>(c2, 0); c1 += xlane<2>(c1, 0); c2 += xlane<2>(c2, 0); c1 += xlane<4>(c1, 0); c2 += xlane<4>(c2, 0);
        if (c == 0) *(f32x2*)(PC + ((size_t)kb * 4096 + ncol0 + n0 + n) * 2) = (f32x2){c1, c2}; }
    LDS_WAIT();
}
__device__ __forceinline__ void transpose_mat_ln(const Frame& F, const float* W, bf16* WT, const float* g, const float* b, float* PC, int ncol0) {
    LAS float* scr = (LAS float*)(F.lds + RING_OFF + F.wave * 16384);
    for (int it = F.gw; it < 32 * 64; it += F.ngw) transpose_item_ln(W, 2048, 2048, WT, scr, it / 64, it % 64, F.lane, g, b, PC, ncol0);
}
__device__ __forceinline__ void colmax_item(const float* W, int ldw, unsigned* CM, int kb, int nb, int lane) {
    const int k0 = 64 * kb, n0 = 32 * nb, n4 = (lane & 7) * 4, kr = lane >> 3;
    float m[4] = {0.f, 0.f, 0.f, 0.f};
#pragma unroll
    for (int i = 0; i < 8; ++i) { const f32x4 v = *(const f32x4*)(W + (size_t)(k0 + 8 * i + kr) * ldw + n0 + n4);
        m[0] = fmaxf(m[0], fabsf(v[0])); m[1] = fmaxf(m[1], fabsf(v[1])); m[2] = fmaxf(m[2], fabsf(v[2])); m[3] = fmaxf(m[3], fabsf(v[3])); }
#pragma unroll
    for (int e = 0; e < 4; ++e) { m[e] = fmaxf(m[e], xlane<8>(m[e], 0)); m[e] = xrow_max(m[e]); }
    if (lane < 8) {
#pragma unroll
        for (int e = 0; e < 4; ++e) { const float me = m[e]; atomicMax(CM + n0 + n4 + e, __float_as_uint(me)); } }
}
__device__ __forceinline__ void colmax_mat(const Frame& F, const float* W, int ldw, unsigned* CM, int nblk = 192) {
    for (int it = F.gw; it < 32 * nblk; it += F.ngw) colmax_item(W, ldw, CM, it / nblk, it % nblk, F.lane);
}
__device__ __forceinline__ unsigned pk4_i8(float a, float b, float c, float d) {
    const int qa = (int)rintf(a), qb = (int)rintf(b), qc = (int)rintf(c), qd = (int)rintf(d);
    return (unsigned)(qa & 0xFF) | ((unsigned)(qb & 0xFF) << 8) | ((unsigned)(qc & 0xFF) << 16) | ((unsigned)qd << 24);
}
__device__ __forceinline__ void transpose_item_i8(const float* W, int ldw, int K, unsigned char* WT8, LAS float* scr, int kb, int nb, int lane, const unsigned* CM, float* SW) {
    const int k0 = 64 * kb, n0 = 32 * nb;
    const int n4 = (lane & 7) * 4, kr = lane >> 3;
    f32x4 inv;
#pragma unroll
    for (int e = 0; e < 4; ++e) { const float cm = __uint_as_float(__hip_atomic_load((unsigned*)CM + n0 + n4 + e, __ATOMIC_RELAXED, __HIP_MEMORY_SCOPE_AGENT)); inv[e] = (cm > 0.f) ? 127.0f / cm : 0.f; if (kb == 0 && kr == 0) SW[n0 + n4 + e] = cm * (1.0f / 127.0f); }
#pragma unroll
    for (int i = 0; i < 8; ++i) { const int kk = 8 * i + kr; const f32x4 v = __builtin_nontemporal_load((const f32x4*)(W + (size_t)(k0 + kk) * ldw + n0 + n4)) * inv;
        scr[kk * 33 + n4] = v[0]; scr[kk * 33 + n4 + 1] = v[1]; scr[kk * 33 + n4 + 2] = v[2]; scr[kk * 33 + n4 + 3] = v[3]; }
    LDS_WAIT();
    const int c = lane & 3;
#pragma unroll
    for (int j = 0; j < 2; ++j) { const int n = (lane >> 2) + 16 * j; const LAS float* sp = scr + (16 * c) * 33 + n;
        v4u o; o.x = pk4_i8(sp[0 * 33], sp[1 * 33], sp[2 * 33], sp[3 * 33]); o.y = pk4_i8(sp[4 * 33], sp[5 * 33], sp[6 * 33], sp[7 * 33]);
        o.z = pk4_i8(sp[8 * 33], sp[9 * 33], sp[10 * 33], sp[11 * 33]); o.w = pk4_i8(sp[12 * 33], sp[13 * 33], sp[14 * 33], sp[15 * 33]);
        *(v4u*)(WT8 + (size_t)(n0 + n) * K + k0 + 16 * c) = o; }
    LDS_WAIT();
}
__device__ __forceinline__ void transpose_mat_i8(const Frame& F, const float* W, int ldw, unsigned char* WT8, const unsigned* CM, float* SW, int nblk = 192) {
    LAS float* scr = (LAS float*)(F.lds + RING_OFF + F.wave * 17920);
    for (int it = F.gw; it < 32 * nblk; it += F.ngw) transpose_item_i8(W, ldw, 2048, WT8, scr, it / nblk, it % nblk, F.lane, CM, SW);
}
__device__ __forceinline__ void colmax_ln_item(const float* W, const float* g, unsigned* CM, int kb, int nb, int lane) {
    const int k0 = 64 * kb, n0 = 32 * nb, n4 = (lane & 7) * 4, kr = lane >> 3;
    float m[4] = {0.f, 0.f, 0.f, 0.f};
#pragma unroll
    for (int i = 0; i < 8; ++i) { const float gk = g[k0 + 8 * i + kr]; const f32x4 v = *(const f32x4*)(W + (size_t)(k0 + 8 * i + kr) * 2048 + n0 + n4);
        m[0] = fmaxf(m[0], fabsf(v[0] * gk)); m[1] = fmaxf(m[1], fabsf(v[1] * gk)); m[2] = fmaxf(m[2], fabsf(v[2] * gk)); m[3] = fmaxf(m[3], fabsf(v[3] * gk)); }
#pragma unroll
    for (int e = 0; e < 4; ++e) { m[e] = fmaxf(m[e], xlane<8>(m[e], 0)); m[e] = xrow_max(m[e]); }
    if (lane < 8) {
#pragma unroll
        for (int e = 0; e < 4; ++e) { const float me = m[e]; atomicMax(CM + n0 + n4 + e, __float_as_uint(me)); } }
}
__device__ __forceinline__ void colmax_ln_mat(const Frame& F, const float* W, const float* g, unsigned* CM) {
    for (int it = F.gw; it < 32 * 64; it += F.ngw) colmax_ln_item(W, g, CM, it / 64, it % 64, F.lane);
}
__device__ __forceinline__ void transpose_item_ln_i8(const float* W, unsigned char* WT8, LAS float* scr, int kb, int nb, int lane, const float* g, const float* b, float* PC, int ncol0, const unsigned* CM, float* SW) {
    const int k0 = 64 * kb, n0 = 32 * nb, K = 2048;
    const int n4 = (lane & 7) * 4, kr = lane >> 3;
    LAS float* scr2 = scr + 64 * 33;
    f32x4 inv;
#pragma unroll
    for (int e = 0; e < 4; ++e) { const float cm = __uint_as_float(__hip_atomic_load((unsigned*)CM + n0 + n4 + e, __ATOMIC_RELAXED, __HIP_MEMORY_SCOPE_AGENT)); inv[e] = (cm > 0.f) ? 127.0f / cm : 0.f; if (kb == 0 && kr == 0) SW[n0 + n4 + e] = cm * (1.0f / 127.0f); }
#pragma unroll
    for (int i = 0; i < 8; ++i) { const int kk = 8 * i + kr; const float gk = g[k0 + kk]; const f32x4 v = __builtin_nontemporal_load((const f32x4*)(W + (size_t)(k0 + kk) * 2048 + n0 + n4)); const f32x4 q = v * inv * gk;
        scr2[kk * 33 + n4] = v[0]; scr2[kk * 33 + n4 + 1] = v[1]; scr2[kk * 33 + n4 + 2] = v[2]; scr2[kk * 33 + n4 + 3] = v[3];
        scr[kk * 33 + n4] = q[0]; scr[kk * 33 + n4 + 1] = q[1]; scr[kk * 33 + n4 + 2] = q[2]; scr[kk * 33 + n4 + 3] = q[3]; }
    LDS_WAIT();
    const int c = lane & 3;
    float bk[16];
#pragma unroll
    for (int i = 0; i < 4; ++i) { const f32x4 bv = *(const f32x4*)(b + k0 + 16 * c + 4 * i); bk[4 * i] = bv[0]; bk[4 * i + 1] = bv[1]; bk[4 * i + 2] = bv[2]; bk[4 * i + 3] = bv[3]; }
#pragma unroll
    for (int j = 0; j < 2; ++j) { const int n = (lane >> 2) + 16 * j; const LAS float* sp = scr + (16 * c) * 33 + n; const LAS float* sr = scr2 + (16 * c) * 33 + n;
        float qv[16]; float sq = 0.f, c2 = 0.f;
#pragma unroll
        for (int i = 0; i < 16; ++i) { qv[i] = rintf(sp[i * 33]); sq += qv[i]; c2 += bk[i] * sr[i * 33]; }
        v4u o; o.x = pk4_i8(qv[0], qv[1], qv[2], qv[3]); o.y = pk4_i8(qv[4], qv[5], qv[6], qv[7]); o.z = pk4_i8(qv[8], qv[9], qv[10], qv[11]); o.w = pk4_i8(qv[12], qv[13], qv[14], qv[15]);
        *(v4u*)(WT8 + (size_t)(n0 + n) * K + k0 + 16 * c) = o;
        sq += xlane<1>(sq, 0); c2 += xlane<1>(c2, 0); sq += xlane<2>(sq, 0); c2 += xlane<2>(c2, 0);
        const float swn = __uint_as_float(__hip_atomic_load((unsigned*)CM + n0 + n, __ATOMIC_RELAXED, __HIP_MEMORY_SCOPE_AGENT)) * (1.0f / 127.0f);
        if (c == 0) *(f32x2*)(PC + ((size_t)kb * 4096 + ncol0 + n0 + n) * 2) = (f32x2){sq * swn, c2}; }
    LDS_WAIT();
}
__device__ __forceinline__ void transpose_mat_ln_i8(const Frame& F, const float* W, unsigned char* WT8, const float* g, const float* b, float* PC, int ncol0, const unsigned* CM, float* SW) {
    LAS float* scr = (LAS float*)(F.lds + RING_OFF + F.wave * 17920);
    for (int it = F.gw; it < 32 * 64; it += F.ngw) transpose_item_ln_i8(W, WT8, scr, it / 64, it % 64, F.lane, g, b, PC, ncol0, CM, SW);
}
__device__ __forceinline__ void quant_rows_i8(const Frame& F, const float* X, unsigned char* X8, float* SX, bf16* XBo) {
    const int lane = F.lane;
    for (int t = F.gw; t < T; t += F.ngw) {
        f32x4 v[8]; float am = 0.f;
#pragma unroll
        for (int i = 0; i < 8; ++i) { v[i] = __builtin_nontemporal_load((const f32x4*)(X + (size_t)t * D + 256 * i + lane * 4));
            am = fmaxf(am, fmaxf(fmaxf(fabsf(v[i][0]), fabsf(v[i][1])), fmaxf(fabsf(v[i][2]), fabsf(v[i][3])))); }
        am = wave_max(am);
        const float inv = (am > 0.f) ? 127.0f / am : 0.f;
        if (lane == 0) SX[t] = am * (1.0f / 127.0f);
#pragma unroll
        for (int i = 0; i < 8; ++i) { *(unsigned*)(X8 + (size_t)t * D + 256 * i + lane * 4) = pk4_i8(v[i][0] * inv, v[i][1] * inv, v[i][2] * inv, v[i][3] * inv);
            v2u o; o.x = pk2(v[i][0], v[i][1]); o.y = pk2(v[i][2], v[i][3]); *(v2u*)(XBo + (size_t)t * D + 256 * i + lane * 4) = o; }
    }
}
__device__ __forceinline__ void transpose_mat(const Frame& F, const float* W, int ldw, int K, int N, bf16* WT) {
    LAS float* scr = (LAS float*)(F.lds + RING_OFF + F.wave * 16384);
    const int nblk = N / 32, items = (K / 64) * nblk;
    for (int it = F.gw; it < items; it += F.ngw) transpose_item(W, ldw, K, WT, scr, it / nblk, it % nblk, F.lane);
}
__device__ __forceinline__ void convert_vec(const Frame& F, const float* src, bf16* dst, size_t n) {
    const size_t nv = n / 8, st = (size_t)F.ngw * 64;
    size_t i = (size_t)F.gw * 64 + F.lane;
    constexpr int U = 4;
    for (; i + (U - 1) * st < nv; i += U * st) {
        f32x4 a[U], b[U];
#pragma unroll
        for (int u = 0; u < U; ++u) { a[u] = __builtin_nontemporal_load((const f32x4*)(src + (i + u * st) * 8)); b[u] = __builtin_nontemporal_load((const f32x4*)(src + (i + u * st) * 8 + 4)); }
#pragma unroll
        for (int u = 0; u < U; ++u) { v4u o; o.x = pk2(a[u][0], a[u][1]); o.y = pk2(a[u][2], a[u][3]); o.z = pk2(b[u][0], b[u][1]); o.w = pk2(b[u][2], b[u][3]); *(v4u*)(dst + (i + u * st) * 8) = o; }
    }
    for (; i < nv; i += st) {
        const f32x4 a = __builtin_nontemporal_load((const f32x4*)(src + i * 8)), b = __builtin_nontemporal_load((const f32x4*)(src + i * 8 + 4));
        v4u o; o.x = pk2(a[0], a[1]); o.y = pk2(a[2], a[3]); o.z = pk2(b[0], b[1]); o.w = pk2(b[2], b[3]);
        *(v4u*)(dst + i * 8) = o;
    }
}
__device__ __forceinline__ float clamp448(float v) { return fminf(fmaxf(v, -448.0f), 448.0f); }
__device__ __forceinline__ unsigned pk4_fp8(const f32x4 a, float sc) {
    int w = 0;
    w = __builtin_amdgcn_cvt_pk_fp8_f32(clamp448(a[0] * sc), clamp448(a[1] * sc), w, false);
    w = __builtin_amdgcn_cvt_pk_fp8_f32(clamp448(a[2] * sc), clamp448(a[3] * sc), w, true);
    return (unsigned)w;
}
__device__ __forceinline__ void convert_fp8(const Frame& F, const float* src, unsigned char* dst, size_t n, float sc) {
    const size_t nv = n / 16;
    for (size_t i = (size_t)F.gw * 64 + F.lane; i < nv; i += (size_t)F.ngw * 64) {
        const f32x4 a = *(const f32x4*)(src + i * 16), b = *(const f32x4*)(src + i * 16 + 4), c = *(const f32x4*)(src + i * 16 + 8), d = *(const f32x4*)(src + i * 16 + 12);
        v4u o; o.x = pk4_fp8(a, sc); o.y = pk4_fp8(b, sc); o.z = pk4_fp8(c, sc); o.w = pk4_fp8(d, sc);
        *(v4u*)(dst + i * 16) = o;
    }
}
__device__ __forceinline__ unsigned pk8_fp4(const f32x4 a, const f32x4 b, float sc) {
    unsigned w = 0u;
    w = __builtin_amdgcn_cvt_scalef32_pk_fp4_f32(w, a[0] * sc, a[1] * sc, 1.0f, 0);
    w = __builtin_amdgcn_cvt_scalef32_pk_fp4_f32(w, a[2] * sc, a[3] * sc, 1.0f, 1);
    w = __builtin_amdgcn_cvt_scalef32_pk_fp4_f32(w, b[0] * sc, b[1] * sc, 1.0f, 2);
    w = __builtin_amdgcn_cvt_scalef32_pk_fp4_f32(w, b[2] * sc, b[3] * sc, 1.0f, 3);
    return w;
}
__device__ __forceinline__ unsigned pk8_int4(const f32x4 a, const f32x4 b, float sc, int off_even, int off_odd) {
    unsigned w = 0u;
#pragma unroll
    for (int i = 0; i < 4; ++i) { const int off = (i & 1) ? off_odd : off_even;
        const int qa = (int)fminf(fmaxf(rintf(a[i] * sc), -8.0f), 7.0f) + off, qb = (int)fminf(fmaxf(rintf(b[i] * sc), -8.0f), 7.0f) + off;
        w |= (unsigned)(qa & 15) << (4 * i); w |= (unsigned)(qb & 15) << (16 + 4 * i); }
    return w;
}
__device__ __forceinline__ void convert_int4(const Frame& F, const float* src, unsigned char* dst, size_t n, float sc, int off_even, int off_odd) {
    const size_t nv = n / 8, st = (size_t)F.ngw * 64;
    size_t i = (size_t)F.gw * 64 + F.lane;
    constexpr int U = 8;
    for (; i + (U - 1) * st < nv; i += U * st) {
        f32x4 a[U], b[U];
#pragma unroll
        for (int u = 0; u < U; ++u) { a[u] = __builtin_nontemporal_load((const f32x4*)(src + (i + u * st) * 8)); b[u] = __builtin_nontemporal_load((const f32x4*)(src + (i + u * st) * 8 + 4)); }
#pragma unroll
        for (int u = 0; u < U; ++u) *(unsigned*)(dst + (i + u * st) * 4) = pk8_int4(a[u], b[u], sc, off_even, off_odd);
    }
    for (; i < nv; i += st)
        *(unsigned*)(dst + i * 4) = pk8_int4(__builtin_nontemporal_load((const f32x4*)(src + i * 8)), __builtin_nontemporal_load((const f32x4*)(src + i * 8 + 4)), sc, off_even, off_odd);
}
__device__ __forceinline__ void convert_fp4(const Frame& F, const float* src, unsigned char* dst, size_t n, float sc) {
    const size_t nv = n / 8;
#pragma unroll 4
    for (size_t i = (size_t)F.gw * 64 + F.lane; i < nv; i += (size_t)F.ngw * 64)
        *(unsigned*)(dst + i * 4) = pk8_fp4(*(const f32x4*)(src + i * 8), *(const f32x4*)(src + i * 8 + 4), sc);
}
__device__ __forceinline__ void p0_prologue(const Frame& F) {
    unsigned char* ws = F.ws;
#if MK_FP8_INPROJ
    for (int l = 0; l < 4; ++l) { const float* g1 = F.ln_gain + (size_t)(l * 2) * D; unsigned* cmq = (unsigned*)(ws + WS_CMQ) + l * 4096;
        colmax_ln_mat(F, F.peer_w_q + (size_t)l * 2048 * 2048, g1, cmq); colmax_ln_mat(F, F.ple_w_gate + (size_t)l * 2048 * 2048, g1, cmq + 2048); }
    for (int l = 0; l < 4; ++l) { const int j = l >> 1;
        if (l & 1) colmax_mat(F, F.odd_w_in + (size_t)j * 2048 * 6160, 6160, (unsigned*)(ws + WS_CM) + l * 6144); else colmax_mat(F, F.even_w_in + (size_t)j * 2048 * 6144, 6144, (unsigned*)(ws + WS_CM) + l * 6144); }
#endif
    for (int l = 0; l < 4; ++l) {
        const int j = l >> 1;
        if ((l & 1) == 0) {
#if !MK_FP8_INPROJ
            transpose_mat(F, F.even_w_in + (size_t)j * 2048 * 6144, 6144, 2048, 6144, (bf16*)(ws + WS_WIN) + (size_t)l * 6144 * 2048);
#endif
#if MK_FP8_INPROJ
            colmax_mat(F, F.even_w_out + (size_t)j * 2048 * 2048, 2048, (unsigned*)(ws + WS_CMO) + l * 2048, 64);
#else
            transpose_mat(F, F.even_w_out + (size_t)j * 2048 * 2048, 2048, 2048, 2048, (bf16*)(ws + WS_WOUT) + (size_t)l * 2048 * 2048);
#endif
        } else {
#if !MK_FP8_INPROJ
            transpose_mat(F, F.odd_w_in + (size_t)j * 2048 * 6160, 6160, 2048, 6144, (bf16*)(ws + WS_WIN) + (size_t)l * 6144 * 2048);
#endif
#if MK_FP8_INPROJ
            colmax_mat(F, F.odd_w_out + (size_t)j * 2048 * 2048, 2048, (unsigned*)(ws + WS_CMO) + l * 2048, 64);
#else
            transpose_mat(F, F.odd_w_out + (size_t)j * 2048 * 2048, 2048, 2048, 2048, (bf16*)(ws + WS_WOUT) + (size_t)l * 2048 * 2048);
#endif
        }
#if !MK_FP8_INPROJ
        { const float* g1 = F.ln_gain + (size_t)(l * 2) * D; const float* b1 = F.ln_bias + (size_t)(l * 2) * D; float* pc = (float*)(ws + WS_PC) + (size_t)l * 32 * 4096 * 2;
          transpose_mat_ln(F, F.peer_w_q + (size_t)l * 2048 * 2048, (bf16*)(ws + WS_WQG) + (size_t)l * 4096 * 2048, g1, b1, pc, 0);
          transpose_mat_ln(F, F.ple_w_gate + (size_t)l * 2048 * 2048, (bf16*)(ws + WS_WQG) + (size_t)l * 4096 * 2048 + (size_t)2048 * 2048, g1, b1, pc, 2048); }
#endif
        transpose_mat(F, F.ple_w_proj + (size_t)l * 256 * 2048, 2048, 256, 2048, (bf16*)(ws + WS_WPJ) + (size_t)l * 2048 * 256);
    }
    { bf16* wgb = (bf16*)(ws + WS_WGB);
      for (int i = F.gw * 64 + F.lane; i < 2 * 16 * 2048; i += F.ngw * 64) { const int j = i / 32768, g = (i / 2048) % 16, k = i % 2048; wgb[i] = (bf16)f2bf(F.odd_w_in[(size_t)j * 2048 * 6160 + (size_t)k * 6160 + 6144 + g]); } }
    for (int l = 0; l < 4; ++l) {
        convert_int4(F, F.peer_u + (size_t)l * 16384 * 2048, ws + WS_UB + (size_t)l * (32u << 20), (size_t)16384 * 2048, 136.0f, 0, 0);
        convert_int4(F, F.peer_v + (size_t)l * 16384 * 2048, ws + WS_UB + (size_t)l * (32u << 20) + (16u << 20), (size_t)16384 * 2048, 20.0f, 8, 0);
    }
    convert_vec(F, F.p, (bf16*)(ws + WS_PB), (size_t)4 * T * 256);
    convert_vec(F, F.peer_sub_keys, (bf16*)(ws + WS_SKB), (size_t)4 * 8 * 2 * 128 * 128);
#if MK_FP8_INPROJ
    quant_rows_i8(F, F.x, ws + WS_X8, (float*)(ws + WS_SX), (bf16*)(ws + WS_XB));
#else
    convert_vec(F, F.x, (bf16*)(ws + WS_XB), (size_t)T * D);
#endif
    { float* cs = (float*)(ws + WS_CS);
      for (int i = F.gw * 64 + F.lane; i < T * 64; i += F.ngw * 64) { const int t = i >> 6, f = i & 63; const float ang = (float)F.pos[t] * powf(10000.0f, -2.0f * (float)f / 128.0f); float sn, cn; sincosf(ang, &sn, &cn); cs[(size_t)t * 128 + f] = cn; cs[(size_t)t * 128 + 64 + f] = sn; } }
}
#if MK_FP8_INPROJ
__device__ __forceinline__ void p0_prologue_b(const Frame& F) {
    unsigned char* ws = F.ws;
    for (int l = 0; l < 4; ++l) { const int j = l >> 1; const unsigned* cm = (const unsigned*)(ws + WS_CM) + l * 6144; float* sw = (float*)(ws + WS_SW) + l * 6144;
        if (l & 1) transpose_mat_i8(F, F.odd_w_in + (size_t)j * 2048 * 6160, 6160, ws + WS_WIN + (size_t)l * 6144 * 2048, cm, sw);
        else transpose_mat_i8(F, F.even_w_in + (size_t)j * 2048 * 6144, 6144, ws + WS_WIN + (size_t)l * 6144 * 2048, cm, sw); }
    for (int l = 0; l < 4; ++l) { const int j = l >> 1; const float* wo = ((l & 1) ? F.odd_w_out : F.even_w_out) + (size_t)j * 2048 * 2048;
        transpose_mat_i8(F, wo, 2048, ws + WS_WOUT + (size_t)l * 2048 * 2048, (const unsigned*)(ws + WS_CMO) + l * 2048, (float*)(ws + WS_SWO) + l * 2048, 64); }
    for (int l = 0; l < 4; ++l) { const float* g1 = F.ln_gain + (size_t)(l * 2) * D; const float* b1 = F.ln_bias + (size_t)(l * 2) * D; float* pc = (float*)(ws + WS_PC) + (size_t)l * 32 * 4096 * 2;
        const unsigned* cmq = (const unsigned*)(ws + WS_CMQ) + l * 4096; float* swq = (float*)(ws + WS_SWQ) + l * 4096; unsigned char* wt = ws + WS_WQG + (size_t)l * 4096 * 2048;
        transpose_mat_ln_i8(F, F.peer_w_q + (size_t)l * 2048 * 2048, wt, g1, b1, pc, 0, cmq, swq);
        transpose_mat_ln_i8(F, F.ple_w_gate + (size_t)l * 2048 * 2048, wt + (size_t)2048 * 2048, g1, b1, pc, 2048, cmq + 2048, swq + 2048); }
}
#endif
__device__ __forceinline__ void unpack8(const v4u w, float (&o)[8]) {
    o[0] = bflo(w.x); o[1] = bfhi(w.x); o[2] = bflo(w.y); o[3] = bfhi(w.y); o[4] = bflo(w.z); o[5] = bfhi(w.z); o[6] = bflo(w.w); o[7] = bfhi(w.w);
}
__device__ __forceinline__ v4u pack8(const float (&v)[8]) { v4u o; o.x = pk2(v[0], v[1]); o.y = pk2(v[2], v[3]); o.z = pk2(v[4], v[5]); o.w = pk2(v[6], v[7]); return o; }

__device__ __forceinline__ void ph_rope_conv(const Frame& F, int j) {
    bf16* HB = (bf16*)(F.ws + WS_HB); bf16* YB = (bf16*)(F.ws + WS_YB);
    const float* cw = F.even_conv_w + (size_t)j * 3 * 1024; const float* CS = (const float*)(F.ws + WS_CS);
    const int lane = fresh_lane();
    const int hd = lane >> 3, fc = lane & 7;
    for (int t = F.gw; t < T; t += F.ngw) {
        const int s = t % S;
        bf16* h0 = HB + (size_t)t * 6144;
        bf16* qp = h0 + 3072 + hd * 128 + 8 * fc; bf16* kp = h0 + 4096 + hd * 128 + 8 * fc;
        const v4u qa = *(const v4u*)qp, qb = *(const v4u*)(qp + 64), ka = *(const v4u*)kp, kb = *(const v4u*)(kp + 64);
        const f32x4 c0 = *(const f32x4*)(CS + (size_t)t * 128 + 8 * fc), c1 = *(const f32x4*)(CS + (size_t)t * 128 + 8 * fc + 4);
        const f32x4 s0 = *(const f32x4*)(CS + (size_t)t * 128 + 64 + 8 * fc), s1 = *(const f32x4*)(CS + (size_t)t * 128 + 64 + 8 * fc + 4);
#pragma unroll
        for (int half = 0; half < 2; ++half) {
            const int cc = lane * 16 + half * 8;
            float acc[8];
#pragma unroll
            for (int i = 0; i < 8; ++i) acc[i] = 0.f;
#pragma unroll
            for (int jj = 0; jj < 3; ++jj) {
                if (s - 2 + jj >= 0) {
                    const bf16* hr = h0 + (ptrdiff_t)(jj - 2) * 6144;
                    float gc[8], xa[8];
                    unpack8(*(const v4u*)(hr + 1024 + cc), gc); unpack8(*(const v4u*)(hr + 2048 + cc), xa);
                    const f32x4 w0 = *(const f32x4*)(cw + jj * 1024 + cc), w1 = *(const f32x4*)(cw + jj * 1024 + cc + 4);
#pragma unroll
                    for (int i = 0; i < 4; ++i) { acc[i] += w0[i] * gc[i] * xa[i]; acc[4 + i] += w1[i] * gc[4 + i] * xa[4 + i]; }
                }
            }
            float gb[8]; unpack8(*(const v4u*)(h0 + cc), gb);
#pragma unroll
            for (int i = 0; i < 8; ++i) acc[i] *= gb[i];
            *(v4u*)(YB + (size_t)t * 2048 + cc) = pack8(acc);
        }
        {
            float cs[8] = {c0[0], c0[1], c0[2], c0[3], c1[0], c1[1], c1[2], c1[3]}, sn[8] = {s0[0], s0[1], s0[2], s0[3], s1[0], s1[1], s1[2], s1[3]};
            float a[8], bq[8], oa[8], ob[8];
            unpack8(qa, a); unpack8(qb, bq);
#pragma unroll
            for (int i = 0; i < 8; ++i) { oa[i] = a[i] * cs[i] - bq[i] * sn[i]; ob[i] = bq[i] * cs[i] + a[i] * sn[i]; }
            *(v4u*)qp = pack8(oa); *(v4u*)(qp + 64) = pack8(ob);
            unpack8(ka, a); unpack8(kb, bq);
#pragma unroll
            for (int i = 0; i < 8; ++i) { oa[i] = a[i] * cs[i] - bq[i] * sn[i]; ob[i] = bq[i] * cs[i] + a[i] * sn[i]; }
            *(v4u*)kp = pack8(oa); *(v4u*)(kp + 64) = pack8(ob);
        }
    }
}

constexpr int AT_KROW = 272, AT_VROW = 528;
constexpr int AT_K_OFF = 0, AT_V_OFF = 256 * AT_KROW;
static_assert(AT_V_OFF + 128 * AT_VROW <= RING_BYTES, "attention LDS");
struct AttnItem { int hd, br, dsh, blk, tok0; };
__device__ __forceinline__ AttnItem attn_decode(int item) {
    AttnItem it; it.hd = item / 384; const int rest = item % 384; it.br = rest >> 7; const int idx = rest & 127;
    it.dsh = 2 * it.br; const int nb = 64 >> it.dsh, b = idx >> 6, r = (idx & 63) / nb; it.blk = (idx & 63) % nb; it.tok0 = b * S + r;
    return it;
}
__device__ __forceinline__ void attn_issue_q(const bf16* HB, const AttnItem& it, int tid, v4u (&qn)[4]) {
    const int wave_ = tid >> 6, l15_ = tid & 15, g_ = (tid & 63) >> 4; const int qtok_ = it.tok0 + ((it.blk * 128 + wave_ * 16 + l15_) << it.dsh);
#pragma unroll
    for (int st = 0; st < 4; ++st) qn[st] = *(const v4u*)(HB + (size_t)qtok_ * 6144 + 3072 + it.hd * 128 + 8 * g_ + 32 * st);
}
__device__ __forceinline__ bool attn_cont(const AttnItem& a, const AttnItem& p) { return a.hd == p.hd && a.br == p.br && a.tok0 == p.tok0 && a.blk == p.blk + 1; }
__device__ __forceinline__ void attn_issue(const bf16* HB, const AttnItem& it, int tid, v4u (&kreg)[8], v4u (&va)[4], v4u (&vb)[4], const bool cont) {
#pragma unroll
    for (int i = 0; i < 8; ++i) {
        if (cont && i < 4) continue;
        const int c = tid + 512 * i, kj = c >> 4, ch = c & 15;
        const int sub = (it.blk - 1) * 128 + kj;
        kreg[i] = (v4u){0u, 0u, 0u, 0u};
        if (sub >= 0) kreg[i] = *(const v4u*)(HB + (size_t)(it.tok0 + (sub << it.dsh)) * 6144 + 4096 + it.hd * 128 + ch * 8);
    }
#pragma unroll
    for (int i = 0; i < 4; ++i) {
        if (cont && i < 2) continue;
        const int u = tid + 512 * i;
        const int kp = ((u >> 8) << 4) | (u & 15), ch = (((u >> 6) & 3) << 2) | ((u >> 4) & 3);
        const int sub0 = (it.blk - 1) * 128 + 2 * kp;
        va[i] = (v4u){0u, 0u, 0u, 0u}; vb[i] = (v4u){0u, 0u, 0u, 0u};
        if (sub0 >= 0) { va[i] = *(const v4u*)(HB + (size_t)(it.tok0 + (sub0 << it.dsh)) * 6144 + 5120 + it.hd * 128 + ch * 8);
                         vb[i] = *(const v4u*)(HB + (size_t)(it.tok0 + ((sub0 + 1) << it.dsh)) * 6144 + 5120 + it.hd * 128 + ch * 8); }
    }
}
__device__ __forceinline__ void ph_attn_mfma(const Frame& F) {
    const bf16* HB = (const bf16*)(F.ws + WS_HB);
    bf16* OG = (bf16*)(F.ws + WS_OG); float* LSE = (float*)(F.ws + WS_LSE);
    LAS unsigned char* lds = F.lds;
    const int tid = (F.wave * 64 + fresh_lane()), lane = tid & 63, wave = F.wave;
    const int l15 = lane & 15, g = lane >> 4;
    const float sc2 = 0.08838834764831845f * 1.4426950408889634f;
    v4u kreg[8], va[4], vb[4], qn[4];
    const int vb0 = (F.nwg % 8 == 0) ? ((F.bid % 8) * (F.nwg / 8) + F.bid / 8) : F.bid;
    const int per = (3072 + F.nwg - 1) / F.nwg, ibase = vb0 * per, iend = (ibase + per < 3072) ? ibase + per : 3072;
    int px = 0; AttnItem itp = attn_decode(0); bool havep = false;
    if (ibase < iend) { const AttnItem it0 = attn_decode(ibase); attn_issue(HB, it0, tid, kreg, va, vb, false); attn_issue_q(HB, it0, tid, qn); }
    for (int item = ibase; item < iend; ++item) {
        const AttnItem it = attn_decode(item);
        const bool cont = havep && attn_cont(it, itp);
        px = cont ? (px ^ 1) : 0;
        itp = it; havep = true;
        const int hd = it.hd, br = it.br, dsh = it.dsh, blk = it.blk, tok0 = it.tok0;
        const int qtok = tok0 + ((blk * 128 + wave * 16 + l15) << dsh);
        v4u qf[4];
#pragma unroll
        for (int st = 0; st < 4; ++st) qf[st] = qn[st];
        __syncthreads();
#pragma unroll
        for (int i = 0; i < 8; ++i) { if (cont && i < 4) continue; const int c = tid + 512 * i, kj = (c >> 4) ^ (px << 7), ch = c & 15; *(LAS v4u*)(lds + AT_K_OFF + kj * AT_KROW + ch * 16) = kreg[i]; }
#pragma unroll
        for (int i = 0; i < 4; ++i) {
            if (cont && i < 2) continue;
            const int u = tid + 512 * i;
            const int kp = (((u >> 8) << 4) | (u & 15)) ^ (px << 6), ch = (((u >> 6) & 3) << 2) | ((u >> 4) & 3);
            const v4u a = va[i], bb = vb[i];
            LAS unsigned char* vbp = lds + AT_V_OFF + (ch * 8) * AT_VROW + kp * 4;
            *(LAS unsigned*)(vbp + 0 * AT_VROW) = (a.x & 0xffffu) | (bb.x << 16);      *(LAS unsigned*)(vbp + 1 * AT_VROW) = (a.x >> 16) | (bb.x & 0xffff0000u);
            *(LAS unsigned*)(vbp + 2 * AT_VROW) = (a.y & 0xffffu) | (bb.y << 16);      *(LAS unsigned*)(vbp + 3 * AT_VROW) = (a.y >> 16) | (bb.y & 0xffff0000u);
            *(LAS unsigned*)(vbp + 4 * AT_VROW) = (a.z & 0xffffu) | (bb.z << 16);      *(LAS unsigned*)(vbp + 5 * AT_VROW) = (a.z >> 16) | (bb.z & 0xffff0000u);
            *(LAS unsigned*)(vbp + 6 * AT_VROW) = (a.w & 0xffffu) | (bb.w << 16);      *(LAS unsigned*)(vbp + 7 * AT_VROW) = (a.w >> 16) | (bb.w & 0xffff0000u);
        }
        __syncthreads();
        if (item + 1 < iend) { const AttnItem itn = attn_decode(item + 1); attn_issue(HB, itn, tid, kreg, va, vb, attn_cont(itn, it)); }
        f32x4 sacc[9];
#pragma unroll
        for (int kt = 0; kt < 9; ++kt) {
            sacc[kt] = (f32x4){0.f, 0.f, 0.f, 0.f};
            const LAS unsigned char* kr = lds + AT_K_OFF + ((16 * (wave + kt) + l15) ^ (px << 7)) * AT_KROW + 16 * g;
#pragma unroll
            for (int st = 0; st < 4; ++st) {
                const bf16x8 af = *(const LAS bf16x8*)(kr + 64 * st);
                sacc[kt] = __builtin_amdgcn_mfma_f32_16x16x32_bf16(af, __builtin_bit_cast(bf16x8, qf[st]), sacc[kt], 0, 0, 0);
            }
        }
        float mx = -INFINITY;
#pragma unroll
        for (int kt = 0; kt < 9; ++kt)
#pragma unroll
            for (int i = 0; i < 4; ++i) {
                const int rel = 16 * kt + 4 * g + i - l15;
                const bool ok = (rel >= 0) && (rel <= 128) && (blk > 0 || (16 * (wave + kt) + 4 * g + i) >= 128);
                const float v = ok ? sacc[kt][i] * sc2 : -INFINITY;
                sacc[kt][i] = v; mx = fmaxf(mx, v);
            }
        mx = xrow_max(mx);
        float sum = 0.f;
#pragma unroll
        for (int kt = 0; kt < 9; ++kt)
#pragma unroll
            for (int i = 0; i < 4; ++i) { const float p = __builtin_amdgcn_exp2f(sacc[kt][i] - mx); sacc[kt][i] = p; sum += p; }
        sum = xrow_sum(sum);
        v4u pf[5];
#pragma unroll
        for (int m = 0; m < 5; ++m) {
            pf[m].x = pk2(sacc[2 * m][0], sacc[2 * m][1]); pf[m].y = pk2(sacc[2 * m][2], sacc[2 * m][3]);
            if (m < 4) { pf[m].z = pk2(sacc[2 * m + 1][0], sacc[2 * m + 1][1]); pf[m].w = pk2(sacc[2 * m + 1][2], sacc[2 * m + 1][3]); } else { pf[m].z = 0u; pf[m].w = 0u; }
        }
        const float rs = 1.0f / sum;
        bf16* orow = OG + ((size_t)br * T + qtok) * 1024 + hd * 128 + 4 * g;
#pragma unroll
        for (int dt = 0; dt < 8; ++dt) {
            f32x4 o = (f32x4){0.f, 0.f, 0.f, 0.f};
            const LAS unsigned char* vr = lds + AT_V_OFF + (16 * dt + l15) * AT_VROW;  const int kv0 = 16 * wave + 4 * g;
#pragma unroll
            for (int m = 0; m < 5; ++m) {
                const v2u p0 = *(const LAS v2u*)(vr + ((kv0 + 32 * m) ^ (px << 7)) * 2);
                const v2u p1 = *(const LAS v2u*)(vr + ((kv0 + 32 * m + (m < 4 ? 16 : 0)) ^ (px << 7)) * 2);
                const v4u af = (v4u){p0.x, p0.y, p1.x, p1.y};
                o = __builtin_amdgcn_mfma_f32_16x16x32_bf16(__builtin_bit_cast(bf16x8, af), __builtin_bit_cast(bf16x8, pf[m]), o, 0, 0, 0);
            }
            v2u w; w.x = pk2(o[0] * rs, o[1] * rs); w.y = pk2(o[2] * rs, o[3] * rs);
            *(v2u*)(orow + 16 * dt) = w;
        }
        if (g == 0) LSE[((size_t)br * T + qtok) * 8 + hd] = mx * 0.6931471805599453f + __logf(sum);
        if (item + 1 < iend) { const AttnItem itn = attn_decode(item + 1); attn_issue_q(HB, itn, tid, qn); }
    }
}
__device__ __forceinline__ void ph_attn_combine(const Frame& F) {
    const bf16* OG = (const bf16*)(F.ws + WS_OG); const float* LSE = (const float*)(F.ws + WS_LSE); bf16* YB = (bf16*)(F.ws + WS_YB);
    const int lane = fresh_lane(), hd = lane >> 3;
    for (int tb = F.gw; tb < T; tb += 2 * F.ngw) {
        v4u og[2][3][2]; float ls[2][3];
#if MK_FP8_INPROJ
        v4u cv[2][2];
#endif
#pragma unroll
        for (int r = 0; r < 2; ++r) { const int t = (tb + r * F.ngw < T) ? tb + r * F.ngw : tb;
#if MK_FP8_INPROJ
            cv[r][0] = *(const v4u*)(YB + (size_t)t * 2048 + lane * 16); cv[r][1] = *(const v4u*)(YB + (size_t)t * 2048 + lane * 16 + 8);
#endif
#pragma unroll
            for (int gq = 0; gq < 3; ++gq) { ls[r][gq] = LSE[((size_t)gq * T + t) * 8 + hd];
                og[r][gq][0] = *(const v4u*)(OG + ((size_t)gq * T + t) * 1024 + lane * 16); og[r][gq][1] = *(const v4u*)(OG + ((size_t)gq * T + t) * 1024 + lane * 16 + 8); } }
#pragma unroll
        for (int r = 0; r < 2; ++r) {
            const int t = tb + r * F.ngw;
            const float m = fmaxf(ls[r][0], fmaxf(ls[r][1], ls[r][2]));
            float w0 = __expf(ls[r][0] - m), w1 = __expf(ls[r][1] - m), w2 = __expf(ls[r][2] - m);
            const float inv = 1.0f / (w0 + w1 + w2); w0 *= inv; w1 *= inv; w2 *= inv;
#if MK_FP8_INPROJ
            float ya[16], yc[16]; float am = 0.f;
#pragma unroll
            for (int hh = 0; hh < 2; ++hh) {
                float a[8], bq[8], c[8], cc[8];
                unpack8(og[r][0][hh], a); unpack8(og[r][1][hh], bq); unpack8(og[r][2][hh], c); unpack8(cv[r][hh], cc);
#pragma unroll
                for (int i = 0; i < 8; ++i) { ya[hh * 8 + i] = w0 * a[i] + w1 * bq[i] + w2 * c[i]; yc[hh * 8 + i] = cc[i]; am = fmaxf(am, fmaxf(fabsf(ya[hh * 8 + i]), fabsf(cc[i]))); }
            }
            am = wave_max(am);
            const float qi = (am > 0.f) ? 127.0f / am : 0.f;
            if (t < T) {
                if (lane == 0) ((float*)(F.ws + WS_SY))[t] = am * (1.0f / 127.0f);
                v4u oc, oa;
                oc.x = pk4_i8(yc[0] * qi, yc[1] * qi, yc[2] * qi, yc[3] * qi); oc.y = pk4_i8(yc[4] * qi, yc[5] * qi, yc[6] * qi, yc[7] * qi); oc.z = pk4_i8(yc[8] * qi, yc[9] * qi, yc[10] * qi, yc[11] * qi); oc.w = pk4_i8(yc[12] * qi, yc[13] * qi, yc[14] * qi, yc[15] * qi);
                oa.x = pk4_i8(ya[0] * qi, ya[1] * qi, ya[2] * qi, ya[3] * qi); oa.y = pk4_i8(ya[4] * qi, ya[5] * qi, ya[6] * qi, ya[7] * qi); oa.z = pk4_i8(ya[8] * qi, ya[9] * qi, ya[10] * qi, ya[11] * qi); oa.w = pk4_i8(ya[12] * qi, ya[13] * qi, ya[14] * qi, ya[15] * qi);
                *(v4u*)(F.ws + WS_Y8 + (size_t)t * 2048 + lane * 16) = oc; *(v4u*)(F.ws + WS_Y8 + (size_t)t * 2048 + 1024 + lane * 16) = oa;
            }
#else
            if (t < T) {
#pragma unroll
                for (int hh = 0; hh < 2; ++hh) {
                    float a[8], bq[8], c[8], y[8];
                    unpack8(og[r][0][hh], a); unpack8(og[r][1][hh], bq); unpack8(og[r][2][hh], c);
#pragma unroll
                    for (int i = 0; i < 8; ++i) y[i] = w0 * a[i] + w1 * bq[i] + w2 * c[i];
                    *(v4u*)(YB + (size_t)t * 2048 + 1024 + lane * 16 + hh * 8) = pack8(y);
                }
            }
#endif
        }
    }
}
__device__ __forceinline__ void ph_quant_y(const Frame& F) {
    const bf16* Y = (const bf16*)(F.ws + WS_YB); unsigned char* Y8 = F.ws + WS_Y8; float* SY = (float*)(F.ws + WS_SY);
    const int lane = fresh_lane();
    for (int tb = F.gw; tb < T; tb += 4 * F.ngw) {
        v4u zr[4][4];
#pragma unroll
        for (int r = 0; r < 4; ++r) { const int t = tb + r * F.ngw;
#pragma unroll
            for (int jj = 0; jj < 4; ++jj) zr[r][jj] = (t < T) ? *(const v4u*)(Y + (size_t)t * D + jj * 512 + lane * 8) : (v4u){0u, 0u, 0u, 0u}; }
#pragma unroll
        for (int r = 0; r < 4; ++r) {
            const int t = tb + r * F.ngw;
            float v[32]; float am = 0.f;
#pragma unroll
            for (int jj = 0; jj < 4; ++jj) { float u8[8]; unpack8(zr[r][jj], u8);
#pragma unroll
                for (int i = 0; i < 8; ++i) { v[jj * 8 + i] = u8[i]; am = fmaxf(am, fabsf(u8[i])); } }
            am = wave_max(am);
            const float inv = (am > 0.f) ? 127.0f / am : 0.f;
            if (t < T) {
                if (lane == 0) SY[t] = am * (1.0f / 127.0f);
#pragma unroll
                for (int jj = 0; jj < 4; ++jj) { v2u o; o.x = pk4_i8(v[jj * 8] * inv, v[jj * 8 + 1] * inv, v[jj * 8 + 2] * inv, v[jj * 8 + 3] * inv); o.y = pk4_i8(v[jj * 8 + 4] * inv, v[jj * 8 + 5] * inv, v[jj * 8 + 6] * inv, v[jj * 8 + 7] * inv);
                    *(v2u*)(Y8 + (size_t)t * D + jj * 512 + lane * 8) = o; }
            }
        }
    }
}

__device__ __forceinline__ void ph_c12(const Frame& F, int layer) {
    const float* pc = (const float*)(F.ws + WS_PC) + (size_t)layer * 32 * 4096 * 2; float* c12 = (float*)(F.ws + WS_C12) + (size_t)layer * 4096 * 2;
    for (int n = F.gw * 64 + fresh_lane(); n < 4096; n += F.ngw * 64) { float c1 = 0.f, c2 = 0.f;
#pragma unroll 8
        for (int kb = 0; kb < 32; ++kb) { const f32x2 v = *(const f32x2*)(pc + ((size_t)kb * 4096 + n) * 2); c1 += v.x; c2 += v.y; }
        *(f32x2*)(c12 + (size_t)n * 2) = (f32x2){c1, c2}; }
}

constexpr int TK_ROW = 272;
constexpr int TK_SK_OFF = 0, TK_IX_OFF = 256 * TK_ROW;
static_assert(TK_IX_OFF + 8 * 2048 <= RING_BYTES, "topk LDS");
__device__ __forceinline__ void ce_desc(float& a, float& b) { const float mx = __builtin_fmaxf(a, b), mn = __builtin_fminf(a, b); a = mx; b = mn; }
__device__ __forceinline__ void sort16_desc(float (&a)[16]) {
#pragma unroll
    for (int k = 2; k <= 16; k <<= 1)
#pragma unroll
        for (int j = k >> 1; j > 0; j >>= 1)
#pragma unroll
            for (int i = 0; i < 16; ++i) { const int l = i ^ j; if (l > i) { if ((i & k) == 0 || k == 16) ce_desc(a[i], a[l]); else ce_desc(a[l], a[i]); } }
}
__device__ __forceinline__ void bitonic_merge16_desc(float (&a)[16]) {
#pragma unroll
    for (int j = 8; j > 0; j >>= 1)
#pragma unroll
        for (int i = 0; i < 16; ++i) { const int l = i ^ j; if (l > i) ce_desc(a[i], a[l]); }
}
__device__ __forceinline__ void sort8_desc(float (&a)[8]) {
#pragma unroll
    for (int k = 2; k <= 8; k <<= 1)
#pragma unroll
        for (int j = k >> 1; j > 0; j >>= 1)
#pragma unroll
            for (int i = 0; i < 8; ++i) { const int l = i ^ j; if (l > i) { if ((i & k) == 0 || k == 8) ce_desc(a[i], a[l]); else ce_desc(a[l], a[i]); } }
}
__device__ __forceinline__ void xlane_merge16(float (&a)[16], int xm, int lane) {
    float b[16];
#pragma unroll
    for (int i = 0; i < 16; ++i) b[i] = shx(a[15 - i], xm, lane);
#pragma unroll
    for (int i = 0; i < 16; ++i) a[i] = __builtin_fmaxf(a[i], b[i]);
    bitonic_merge16_desc(a);
}
__device__ __forceinline__ float packlow(float x, unsigned code, unsigned mask) { return __builtin_bit_cast(float, (__builtin_bit_cast(unsigned, x) & ~mask) | code); }
__device__ __forceinline__ float sel4(int g, float x0, float x1, float x2, float x3) { return (g == 0) ? x0 : ((g == 1) ? x1 : ((g == 2) ? x2 : x3)); }

__device__ __forceinline__ void ph_topk(const Frame& F, int layer) {
    const bf16* QB = (const bf16*)(F.ws + WS_QB); int* IDX = (int*)(F.ws + WS_IDX); float* GWt = (float*)(F.ws + WS_GW);
    const bf16* SKB = (const bf16*)(F.ws + WS_SKB) + (size_t)layer * 8 * 2 * 128 * 128;
    LAS unsigned char* lds = F.lds;
    const int tid = (F.wave * 64 + fresh_lane()), lane = tid & 63, wave = F.wave, l15 = lane & 15, g = lane >> 4;
    LAS int* ixl = (LAS int*)(lds + TK_IX_OFF + wave * 2048 + l15 * 128);
    const float NEG = -3.0e38f;
    int h_staged = -1;
    v4u qfa[2][4];
    if (F.bid < 1024) { const int hd0 = F.bid & 7, t0q = (F.bid >> 3) * 128 + wave * 16 + l15;
#pragma unroll
        for (int p = 0; p < 2; ++p)
#pragma unroll
            for (int st = 0; st < 4; ++st) qfa[p][st] = *(const v4u*)(QB + (size_t)t0q * 2048 + hd0 * 256 + p * 128 + 8 * g + 32 * st); }
    for (int item = F.bid; item < 1024; item += F.nwg) {
        const int hd = item & 7, tb = item >> 3;
        if (hd != h_staged) {
            __syncthreads();
#pragma unroll
            for (int i = 0; i < 8; ++i) { const int c = tid + 512 * i, row = c >> 4, ch = c & 15;
                *(LAS v4u*)(lds + TK_SK_OFF + row * TK_ROW + ch * 16) = *(const v4u*)(SKB + ((size_t)hd * 256 + row) * 128 + ch * 8); }
            __syncthreads();
            h_staged = hd;
        }
        const int t = tb * 128 + wave * 16 + l15;
        float v1[16], v2[16];
#pragma unroll
        for (int p = 0; p < 2; ++p) {
            const v4u (&qf)[4] = qfa[p];
            float lo[16], hi[16];
#pragma unroll
            for (int kt = 0; kt < 8; ++kt) {
                f32x4 acc = (f32x4){0.f, 0.f, 0.f, 0.f};
                const LAS unsigned char* kr = lds + TK_SK_OFF + (p * 128 + 16 * kt + l15) * TK_ROW + 16 * g;
#pragma unroll
                for (int st = 0; st < 4; ++st) acc = __builtin_amdgcn_mfma_f32_16x16x32_bf16(*(const LAS bf16x8*)(kr + 64 * st), __builtin_bit_cast(bf16x8, qf[st]), acc, 0, 0, 0);
#pragma unroll
                for (int i = 0; i < 4; ++i) { const float pv = packlow(acc[i], (unsigned)(16 * kt + 4 * g + i), 0x7Fu); if (kt < 4) lo[4 * kt + i] = pv; else hi[4 * (kt - 4) + i] = pv; }
            }
            sort16_desc(lo); sort16_desc(hi);
#pragma unroll
            for (int i = 0; i < 16; ++i) lo[i] = __builtin_fmaxf(lo[i], hi[15 - i]);
            bitonic_merge16_desc(lo);
            xlane_merge16(lo, 16, lane); xlane_merge16(lo, 32, lane);
#pragma unroll
            for (int i = 0; i < 16; ++i) { if (p == 0) v1[i] = lo[i]; else v2[i] = lo[i]; }
        }
        if (item + F.nwg < 1024) { const int itn = item + F.nwg, hdn = itn & 7, tn = (itn >> 3) * 128 + wave * 16 + l15;
#pragma unroll
            for (int p = 0; p < 2; ++p)
#pragma unroll
                for (int st = 0; st < 4; ++st) qfa[p][st] = *(const v4u*)(QB + (size_t)tn * 2048 + hdn * 256 + p * 128 + 8 * g + 32 * st); }
        if (g == 0) {
#pragma unroll
            for (int i = 0; i < 16; ++i) { ixl[i] = (int)(__builtin_bit_cast(unsigned, v1[i]) & 0x7Fu); ixl[16 + i] = (int)(__builtin_bit_cast(unsigned, v2[i]) & 0x7Fu); }
        }
        float c[16], e[8];
        {
            const float s0 = sel4(g, v1[0], v1[1], v1[2], v1[3]), s1 = sel4(g, v1[4], v1[5], v1[6], v1[7]);
            const float s2 = sel4(g, v1[8], v1[9], v1[10], v1[11]), s3 = sel4(g, v1[12], v1[13], v1[14], v1[15]);
            const int n0 = (g == 0) ? 16 : ((g == 1) ? 8 : ((g == 2) ? 5 : 4));
#pragma unroll
            for (int bq = 0; bq < 16; ++bq) c[bq] = (bq < n0) ? packlow(s0 + v2[bq], (unsigned)((g << 4) | bq), 0xFFu) : NEG;
            e[0] = packlow(s1 + v2[0], (unsigned)(((4 + g) << 4) | 0), 0xFFu);
            e[1] = packlow(s1 + v2[1], (unsigned)(((4 + g) << 4) | 1), 0xFFu);
            e[2] = (g == 0) ? packlow(s1 + v2[2], (unsigned)((4 << 4) | 2), 0xFFu) : NEG;
            e[3] = packlow(s2 + v2[0], (unsigned)(((8 + g) << 4) | 0), 0xFFu);
            e[4] = packlow(s3 + v2[0], (unsigned)(((12 + g) << 4) | 0), 0xFFu);
            e[5] = NEG; e[6] = NEG; e[7] = NEG;
        }
        sort8_desc(e);
#pragma unroll
        for (int i = 8; i < 16; ++i) c[i] = __builtin_fmaxf(c[i], e[15 - i]);
        bitonic_merge16_desc(c);
        xlane_merge16(c, 16, lane); xlane_merge16(c, 32, lane);
        float r[4], ex[4], esum = 0.f;
#pragma unroll
        for (int i = 0; i < 4; ++i) { r[i] = sel4(g, c[i], c[4 + i], c[8 + i], c[12 + i]); ex[i] = __expf(r[i] - c[0]); esum += ex[i]; }
        esum = xrow_sum(esum);
        const float rinv = 1.0f / esum;
        LDS_WAIT();
        int ido[4]; float go[4];
#pragma unroll
        for (int i = 0; i < 4; ++i) { const unsigned code = __builtin_bit_cast(unsigned, r[i]) & 0xFFu; ido[i] = ixl[code >> 4] * 128 + ixl[16 + (code & 15u)]; go[i] = ex[i] * rinv; }
        *(int4*)(IDX + (size_t)t * 128 + hd * 16 + 4 * g) = make_int4(ido[0], ido[1], ido[2], ido[3]);
        *(f32x4*)(GWt + (size_t)t * 128 + hd * 16 + 4 * g) = (f32x4){go[0], go[1], go[2], go[3]};
        LDS_WAIT();
    }
}

__device__ __forceinline__ float rdlane_f(float v, int l) { return __builtin_bit_cast(float, __builtin_amdgcn_readlane(__builtin_bit_cast(int, v), l)); }
constexpr float U4_SCALE = 136.0f, V4_SCALE = 20.0f;
constexpr unsigned ROW4 = 1024u, TAB4 = 16384u * 1024u;
__device__ __forceinline__ f32x2 dot8_fp4(const unsigned w, const f32x2* x, f32x2 a) {
    a += __builtin_amdgcn_cvt_scalef32_pk_f32_fp4(w, 1.0f, 0) * x[0]; a += __builtin_amdgcn_cvt_scalef32_pk_f32_fp4(w, 1.0f, 1) * x[1];
    a += __builtin_amdgcn_cvt_scalef32_pk_f32_fp4(w, 1.0f, 2) * x[2]; a += __builtin_amdgcn_cvt_scalef32_pk_f32_fp4(w, 1.0f, 3) * x[3];
    return a;
}
__device__ __forceinline__ void axpy8_fp4(const unsigned w, const float wt, f32x2* acc) {
    const f32x2 w2 = {wt, wt};
    acc[0] += __builtin_amdgcn_cvt_scalef32_pk_f32_fp4(w, 1.0f, 0) * w2; acc[1] += __builtin_amdgcn_cvt_scalef32_pk_f32_fp4(w, 1.0f, 1) * w2;
    acc[2] += __builtin_amdgcn_cvt_scalef32_pk_f32_fp4(w, 1.0f, 2) * w2; acc[3] += __builtin_amdgcn_cvt_scalef32_pk_f32_fp4(w, 1.0f, 3) * w2;
}
__device__ __forceinline__ void gather_sorted_ids(const int* IDX, const float* GWt, int t, int lane, int& id0, int& id1, float& g0, float& g1) {
    const int ia = IDX[(size_t)t * 128 + lane], ib = IDX[(size_t)t * 128 + 64 + lane];
    const float ga = GWt[(size_t)t * 128 + lane], gb = GWt[(size_t)t * 128 + 64 + lane];
    unsigned a = ((unsigned)ia << 16) | (unsigned)fminf(ga * 65536.0f, 65535.0f), b = ((unsigned)ib << 16) | (unsigned)fminf(gb * 65536.0f, 65535.0f);
#pragma unroll
    for (int k = 2; k <= 128; k <<= 1) {
        if (k == 128) { const unsigned mn = a < b ? a : b, mx = a < b ? b : a; a = mn; b = mx; }
#pragma unroll
        for (int j = (k >= 128 ? 32 : k >> 1); j > 0; j >>= 1) {
            const bool lower = (lane & j) == 0;
            const bool upa = (k >= 128) ? true : ((lane & k) == 0);
            const bool upb = (k >= 128) ? true : (k == 64 ? false : ((lane & k) == 0));
            const unsigned oa = (unsigned)shx_i((int)a, j, lane), ob = (unsigned)shx_i((int)b, j, lane);
            a = (lower == upa) ? (a < oa ? a : oa) : (a < oa ? oa : a);
            b = (lower == upb) ? (b < ob ? b : ob) : (b < ob ? ob : b);
        }
    }
    id0 = (int)(a >> 16); id1 = (int)(b >> 16);
    g0 = ((float)(a & 0xffffu) + 0.5f) * (1.0f / 65536.0f); g1 = ((float)(b & 0xffffu) + 0.5f) * (1.0f / 65536.0f);
}
__device__ __forceinline__ float gelu_as(float v) {
    const float av = fabsf(v), t = __builtin_amdgcn_rcpf(av * 0.2316418882f + 1.0f);
    float q = t * 0.5307027145f + (-0.7265760135f); q = q * t + 0.7107068705f; q = q * t + (-0.142248368f); q = q * t + 0.127414796f; q = q * t;
    const float m = v * (q * __builtin_amdgcn_exp2f((v * v) * (-0.72134752044f)));
    return v < 0.f ? m : v - m;
}
__device__ __forceinline__ void ph_quant_z(const Frame& F, int layer) {
    const bf16* Z = (const bf16*)(F.ws + WS_ZF); unsigned char* Z8 = F.ws + WS_Z8; float* RS = (float*)(F.ws + WS_RS);
    unsigned* XQ = (unsigned*)(F.ws + WS_XQ); float* R4 = (float*)(F.ws + WS_R4);
    const float* gain1 = F.ln_gain + (size_t)(layer * 2) * D; const float* bias1 = F.ln_bias + (size_t)(layer * 2) * D;
    const int lane = fresh_lane();
    for (int tb = F.gw; tb < T; tb += 4 * F.ngw) {
        v4u zr[4][4];
#pragma unroll
        for (int r = 0; r < 4; ++r) { const int t = tb + r * F.ngw;
#pragma unroll
            for (int jj = 0; jj < 4; ++jj) zr[r][jj] = (t < T) ? *(const v4u*)(Z + (size_t)t * D + jj * 512 + lane * 8) : (v4u){0u, 0u, 0u, 0u}; }
#pragma unroll
        for (int r = 0; r < 4; ++r) {
            const int t = tb + r * F.ngw;
            float v[32]; float s = 0.f, am = 0.f;
#pragma unroll
            for (int jj = 0; jj < 4; ++jj) { float u8[8]; unpack8(zr[r][jj], u8);
#pragma unroll
                for (int i = 0; i < 8; ++i) { v[jj * 8 + i] = u8[i]; s += u8[i]; am = fmaxf(am, fabsf(u8[i])); } }
            const float mean = wave_sum(s) * (1.0f / D); float q = 0.f;
#pragma unroll
            for (int i = 0; i < 32; ++i) { const float d = v[i] - mean; q += d * d; }
            const float rstd = ln_rstd(wave_sum(q));
            am = wave_max(am);
            const float inv = (am > 0.f) ? 127.0f / am : 0.f;
            if (t < T) {
                if (lane == 0) *(f32x2*)(RS + (size_t)t * 2) = (f32x2){rstd * am * (1.0f / 127.0f), -mean * rstd};
#pragma unroll
                for (int jj = 0; jj < 4; ++jj) { v2u o; o.x = pk4_i8(v[jj * 8] * inv, v[jj * 8 + 1] * inv, v[jj * 8 + 2] * inv, v[jj * 8 + 3] * inv); o.y = pk4_i8(v[jj * 8 + 4] * inv, v[jj * 8 + 5] * inv, v[jj * 8 + 6] * inv, v[jj * 8 + 7] * inv);
                    *(v2u*)(Z8 + (size_t)t * D + jj * 512 + lane * 8) = o; }
            }
            float ax = 0.f;
#pragma unroll
            for (int jj = 0; jj < 4; ++jj) { const int c = jj * 512 + lane * 8;
                const f32x4 g0 = *(const f32x4*)(gain1 + c), g1 = *(const f32x4*)(gain1 + c + 4), b0 = *(const f32x4*)(bias1 + c), b1 = *(const f32x4*)(bias1 + c + 4);
#pragma unroll
                for (int i = 0; i < 4; ++i) { v[jj * 8 + i] = (v[jj * 8 + i] - mean) * rstd * g0[i] + b0[i]; v[jj * 8 + 4 + i] = (v[jj * 8 + 4 + i] - mean) * rstd * g1[i] + b1[i];
                    ax = fmaxf(ax, fmaxf(fabsf(v[jj * 8 + i]), fabsf(v[jj * 8 + 4 + i]))); } }
            ax = fmaxf(wave_max(ax), 1e-20f);
            const float xs = 119.0f / ax;
            if (t < T) {
                if (lane == 0) *(f32x4*)(R4 + (size_t)t * 4) = (f32x4){ax * (1.0f / 119.0f) * (1.0f / U4_SCALE), mean, rstd, 0.f};
#pragma unroll
                for (int jj = 0; jj < 4; ++jj) { unsigned ph = 0u, pl = 0u;
#pragma unroll
                    for (int i = 0; i < 8; ++i) { const int x8 = (int)rintf(v[jj * 8 + i] * xs); const int lo = ((x8 + 8) & 15) - 8, hi = (x8 - lo) >> 4;
                        ph |= (unsigned)(hi & 15) << (4 * i); pl |= (unsigned)(lo & 15) << (4 * i); }
                    unsigned* dst = XQ + (size_t)t * 512 + (jj * 16 + (lane >> 2)) * 8 + (lane & 3);
                    dst[0] = ph; dst[4] = pl; }
            }
        }
    }
}

__device__ __forceinline__ void ph_gather_ln2(const Frame& F, int layer, int dummy = 0) {
    const unsigned char* UV4 = (const unsigned char*)(F.ws + WS_UB) + (size_t)layer * (2u * TAB4);
    const bf16* ZB = (const bf16*)(F.ws + WS_ZF); const bf16* PLE = (const bf16*)(F.ws + WS_PLE);
    const int* IDX = (const int*)(F.ws + WS_IDX); const float* GWt = (const float*)(F.ws + WS_GW);
    float* OF = (layer == 3 && !dummy) ? F.out : (float*)nullptr; bf16* XB = (bf16*)(F.ws + (dummy ? WS_X1B : WS_XB));
#ifdef PROBE_GATHER_MASK
    const int idmask = (dummy == 1) ? PROBE_GATHER_MASK : 0x3fff;
#endif
    const float* gain1 = F.ln_gain + (size_t)(layer * 2) * D; const float* bias1 = F.ln_bias + (size_t)(layer * 2) * D;
    const float* gain = F.ln_gain + (size_t)(layer * 2 + 1) * D; const float* bias = F.ln_bias + (size_t)(layer * 2 + 1) * D;
    const int lane = fresh_lane();
    const bool b3 = (lane & 8) != 0, b2 = (lane & 4) != 0, b1 = (lane & 2) != 0, b0 = (lane & 1) != 0;
    const __amdgpu_buffer_rsrc_t rs = __builtin_amdgcn_make_buffer_rsrc((void*)UV4, (short)0, (int)(2u * TAB4), 0x00020000);
    const unsigned voff = (unsigned)lane * 16u;
    v4u ring[16];
    int id0 = 0, id1 = 0, id0n = 0;
#define GATHER_ISSUE(k, sn_) do { const int sn = (sn_); const int secn = (sn >> 6) & 3; \
        const int idsel = (sn >= 256) ? id0n : ((secn & 1) ? id1 : id0); \
        const unsigned so = (unsigned)__builtin_amdgcn_readlane(idsel, sn & 63) * ROW4 + ((secn >= 2) ? TAB4 : 0u); \
        ring[k] = __builtin_bit_cast(v4u, __builtin_amdgcn_raw_buffer_load_b128(rs, voff, so, 0)); } while (0)
    int id1n = 0; float g0n = 0.f, g1n = 0.f;
    if (F.gw < T) { gather_sorted_ids(IDX, GWt, F.gw, lane, id0n, id1n, g0n, g1n);
#ifdef PROBE_GATHER_MASK
        id0n &= idmask; id1n &= idmask;
#endif
#pragma unroll
        for (int k = 0; k < 16; ++k) GATHER_ISSUE(k, 256 + k); }
    for (int t = F.gw; t < T; t += F.ngw) {
        int xh[4], xl[4]; float xdq, mean1, rstd1;
        {
            const v4u hq = *(const v4u*)(F.ws + WS_XQ + (size_t)t * 2048 + lane * 32), lq = *(const v4u*)(F.ws + WS_XQ + (size_t)t * 2048 + lane * 32 + 16);
            const f32x4 r4 = *(const f32x4*)(F.ws + WS_R4 + (size_t)t * 16);
            xh[0] = (int)hq.x; xh[1] = (int)hq.y; xh[2] = (int)hq.z; xh[3] = (int)hq.w; xl[0] = (int)lq.x; xl[1] = (int)lq.y; xl[2] = (int)lq.z; xl[3] = (int)lq.w;
            xdq = r4[0]; mean1 = r4[1]; rstd1 = r4[2];
        }
        if (t - F.wave + (NWAVES - 1) < T) __syncthreads();
        id0 = id0n; id1 = id1n; const float g0 = g0n, g1 = g1n;
        { const int tn = (t + F.ngw < T) ? t + F.ngw : t; gather_sorted_ids(IDX, GWt, tn, lane, id0n, id1n, g0n, g1n);
#ifdef PROBE_GATHER_MASK
          id0n &= idmask; id1n &= idmask;
#endif
        }
        float w0 = 0.f, w1 = 0.f;
#define GATHER_U_SECTION(SEC, GREG, WREG) \
        _Pragma("nounroll") for (int grp = 0; grp < 4; ++grp) { \
            const int s0 = (SEC) * 64 + grp * 16; \
            float P[16]; \
            _Pragma("unroll") for (int k = 0; k < 16; ++k) { \
                int ia = 0, ib = 0; \
                ia = __builtin_amdgcn_sdot8((int)ring[k].x, xh[0], ia, false); ib = __builtin_amdgcn_sdot8((int)ring[k].x, xl[0], ib, false); \
                ia = __builtin_amdgcn_sdot8((int)ring[k].y, xh[1], ia, false); ib = __builtin_amdgcn_sdot8((int)ring[k].y, xl[1], ib, false); \
                ia = __builtin_amdgcn_sdot8((int)ring[k].z, xh[2], ia, false); ib = __builtin_amdgcn_sdot8((int)ring[k].z, xl[2], ib, false); \
                ia = __builtin_amdgcn_sdot8((int)ring[k].w, xh[3], ia, false); ib = __builtin_amdgcn_sdot8((int)ring[k].w, xl[3], ib, false); \
                P[k] = (float)(16 * ia + ib); \
                GATHER_ISSUE(k, s0 + k + 16); __builtin_amdgcn_sched_barrier(0); } \
            _Pragma("unroll") for (int i = 0; i < 8; ++i) { const float keep = b3 ? P[i + 8] : P[i], send = b3 ? P[i] : P[i + 8]; P[i] = keep + shx(send, 8, lane); } \
            _Pragma("unroll") for (int i = 0; i < 4; ++i) { const float keep = b2 ? P[i + 4] : P[i], send = b2 ? P[i] : P[i + 4]; P[i] = keep + shx(send, 4, lane); } \
            _Pragma("unroll") for (int i = 0; i < 2; ++i) { const float keep = b1 ? P[i + 2] : P[i], send = b1 ? P[i] : P[i + 2]; P[i] = keep + shx(send, 2, lane); } \
            { const float keep = b0 ? P[1] : P[0], send = b0 ? P[0] : P[1]; P[0] = keep + shx(send, 1, lane); } \
            const float tot = xrow_sum(P[0]); \
            const float hid = tot * xdq; \
            const float ge = gelu_as(hid) * (1.0f / V4_SCALE); \
            if ((lane >> 4) == grp) WREG = GREG * ge; }
#define GATHER_TR4DOT(a0, a1, a2, a3, o) do { \
        const unsigned pa_ = __builtin_amdgcn_perm(a1, a0, 0x05010400u), pb_ = __builtin_amdgcn_perm(a1, a0, 0x07030602u), pc_ = __builtin_amdgcn_perm(a3, a2, 0x05010400u), pd_ = __builtin_amdgcn_perm(a3, a2, 0x07030602u); \
        const unsigned t0_ = __builtin_amdgcn_perm(pc_, pa_, 0x05040100u), t1_ = __builtin_amdgcn_perm(pc_, pa_, 0x07060302u), t2_ = __builtin_amdgcn_perm(pd_, pb_, 0x05040100u), t3_ = __builtin_amdgcn_perm(pd_, pb_, 0x07060302u); \
        acci[(o)]     = __builtin_amdgcn_sdot4((int)t0_, wpk, acci[(o)], false);     acci[(o) + 1] = __builtin_amdgcn_sdot4((int)(t0_ & 0xF0F0F0F0u), wpk, acci[(o) + 1], false); \
        acci[(o) + 2] = __builtin_amdgcn_sdot4((int)t1_, wpk, acci[(o) + 2], false); acci[(o) + 3] = __builtin_amdgcn_sdot4((int)(t1_ & 0xF0F0F0F0u), wpk, acci[(o) + 3], false); \
        acci[(o) + 4] = __builtin_amdgcn_sdot4((int)t2_, wpk, acci[(o) + 4], false); acci[(o) + 5] = __builtin_amdgcn_sdot4((int)(t2_ & 0xF0F0F0F0u), wpk, acci[(o) + 5], false); \
        acci[(o) + 6] = __builtin_amdgcn_sdot4((int)t3_, wpk, acci[(o) + 6], false); acci[(o) + 7] = __builtin_amdgcn_sdot4((int)(t3_ & 0xF0F0F0F0u), wpk, acci[(o) + 7], false); } while (0)
#define GATHER_V_SECTION(SEC, PKREG) \
        _Pragma("nounroll") for (int grp = 0; grp < 4; ++grp) { \
            const int s0 = (SEC) * 64 + grp * 16; \
            _Pragma("unroll") for (int sub = 0; sub < 4; ++sub) { \
                const int wpk = __builtin_amdgcn_readlane(PKREG, grp * 16 + sub * 4); \
                _Pragma("unroll") for (int q = 0; q < 4; ++q) { \
                    GATHER_TR4DOT(ring[4 * sub][q], ring[4 * sub + 1][q], ring[4 * sub + 2][q], ring[4 * sub + 3][q], 8 * q); } \
                _Pragma("unroll") for (int i = 0; i < 4; ++i) GATHER_ISSUE(4 * sub + i, s0 + 4 * sub + i + 16); \
                __builtin_amdgcn_sched_barrier(0); } }
        GATHER_U_SECTION(0, g0, w0)
        GATHER_U_SECTION(1, g1, w1)
        const float wm = wave_max(fmaxf(fabsf(w0), fabsf(w1)));
        const float wsq = (wm > 0.f) ? 127.0f / wm : 0.f;
        const int q0 = (int)rintf(w0 * wsq), q1 = (int)rintf(w1 * wsq);
        const int c8 = 8 * (int)wave_sum((float)(q0 + q1));
        const int pk0 = (q0 & 0xFF) | ((shl_i(q0, lane + 1) & 0xFF) << 8) | ((shl_i(q0, lane + 2) & 0xFF) << 16) | (shl_i(q0, lane + 3) << 24);
        const int pk1 = (q1 & 0xFF) | ((shl_i(q1, lane + 1) & 0xFF) << 8) | ((shl_i(q1, lane + 2) & 0xFF) << 16) | (shl_i(q1, lane + 3) << 24);
        int acci[32];
#pragma unroll
        for (int i = 0; i < 32; ++i) acci[i] = 0;
        GATHER_V_SECTION(2, pk0)
        GATHER_V_SECTION(3, pk1)
#undef GATHER_U_SECTION
#undef GATHER_V_SECTION
#undef GATHER_TR4DOT
        f32x2 acc[16];
        { const float fsc = wm * (1.0f / 127.0f);
#pragma unroll
          for (int i = 0; i < 16; ++i) acc[i] = (f32x2){(float)(acci[2 * i] - acci[2 * i + 1] - c8) * fsc, (float)acci[2 * i + 1] * (fsc * 0.0625f)}; }
        const int lane2 = ov(lane);
        float s = 0.f;
#pragma unroll
        for (int hh = 0; hh < 4; ++hh) { float pl[8]; unpack8(*(const v4u*)(PLE + (size_t)t * D + lane2 * 32 + hh * 8), pl);
            float z8[8]; unpack8(*(const v4u*)(ZB + (size_t)t * D + lane2 * 32 + hh * 8), z8);
            f32x4 xa = (f32x4){z8[0], z8[1], z8[2], z8[3]}, xb = (f32x4){z8[4], z8[5], z8[6], z8[7]};
            xa = (xa - mean1) * rstd1 * *(const f32x4*)(gain1 + lane2 * 32 + hh * 8) + *(const f32x4*)(bias1 + lane2 * 32 + hh * 8);
            xb = (xb - mean1) * rstd1 * *(const f32x4*)(gain1 + lane2 * 32 + hh * 8 + 4) + *(const f32x4*)(bias1 + lane2 * 32 + hh * 8 + 4);
            acc[hh * 4 + 0] += (f32x2){ALPHA * xa[0] + pl[0], ALPHA * xa[1] + pl[1]}; acc[hh * 4 + 1] += (f32x2){ALPHA * xa[2] + pl[2], ALPHA * xa[3] + pl[3]};
            acc[hh * 4 + 2] += (f32x2){ALPHA * xb[0] + pl[4], ALPHA * xb[1] + pl[5]}; acc[hh * 4 + 3] += (f32x2){ALPHA * xb[2] + pl[6], ALPHA * xb[3] + pl[7]};
#pragma unroll
            for (int i = 0; i < 4; ++i) s += acc[hh * 4 + i].x + acc[hh * 4 + i].y; }
        const float mean = wave_sum(s) * (1.0f / D); float q = 0.f;
#pragma unroll
        for (int i = 0; i < 16; ++i) { acc[i].x -= mean; acc[i].y -= mean; q += acc[i].x * acc[i].x + acc[i].y * acc[i].y; }
        const float rstd = ln_rstd(wave_sum(q));
#pragma unroll
        for (int hh = 0; hh < 4; ++hh) {
            const int c = lane2 * 32 + hh * 8;
            float y[8];
#pragma unroll
            for (int q4 = 0; q4 < 2; ++q4) { const f32x4 ga = *(const f32x4*)(gain + c + q4 * 4), ba = *(const f32x4*)(bias + c + q4 * 4);
                const f32x2 z0 = acc[hh * 4 + q4 * 2], z1 = acc[hh * 4 + q4 * 2 + 1];
                f32x4 yo; yo[0] = z0.x * rstd * ga[0] + ba[0]; yo[1] = z0.y * rstd * ga[1] + ba[1]; yo[2] = z1.x * rstd * ga[2] + ba[2]; yo[3] = z1.y * rstd * ga[3] + ba[3];
                if (OF) *(f32x4*)(OF + (size_t)t * D + c + q4 * 4) = yo;
                y[q4 * 4] = yo[0]; y[q4 * 4 + 1] = yo[1]; y[q4 * 4 + 2] = yo[2]; y[q4 * 4 + 3] = yo[3]; }
            if (!OF) *(v4u*)(XB + (size_t)t * D + c) = pack8(y);
#if MK_FP8_INPROJ
            acc[hh * 4 + 0] = (f32x2){y[0], y[1]}; acc[hh * 4 + 1] = (f32x2){y[2], y[3]}; acc[hh * 4 + 2] = (f32x2){y[4], y[5]}; acc[hh * 4 + 3] = (f32x2){y[6], y[7]};
#endif
        }
#if MK_FP8_INPROJ
        if (!dummy && !OF) {
            float am = 0.f;
#pragma unroll
            for (int i = 0; i < 16; ++i) am = fmaxf(am, fmaxf(fabsf(acc[i].x), fabsf(acc[i].y)));
            am = wave_max(am);
            const float inv = (am > 0.f) ? 127.0f / am : 0.f;
            if (lane2 == 0) ((float*)(F.ws + WS_SX))[t] = am * (1.0f / 127.0f);
#pragma unroll
            for (int hh = 0; hh < 4; ++hh) { v2u y8; y8.x = pk4_i8(acc[hh * 4].x * inv, acc[hh * 4].y * inv, acc[hh * 4 + 1].x * inv, acc[hh * 4 + 1].y * inv);
                y8.y = pk4_i8(acc[hh * 4 + 2].x * inv, acc[hh * 4 + 2].y * inv, acc[hh * 4 + 3].x * inv, acc[hh * 4 + 3].y * inv);
                *(v2u*)(F.ws + WS_X8 + (size_t)t * D + lane2 * 32 + hh * 8) = y8; }
        }
#endif
    }
#undef GATHER_ISSUE
}

constexpr size_t ML_BCUM = 0, ML_IPRE = 512 * 1024, ML_NLOC = 1024 * 1024, ML_BTOT = 1536 * 1024, ML_MLOC = 1540 * 1024, ML_MPREV = 1544 * 1024;
constexpr int ML_ROW = 272;
constexpr int ML_SM_OFF = 0, ML_K_OFF = 4096, ML_V_OFF = ML_K_OFF + 128 * ML_ROW;
static_assert(ML_V_OFF + 256 * ML_ROW <= RING_BYTES, "mLSTM LDS");

__device__ __forceinline__ void ml_stage_vt(const bf16* HB, int t0, int h, LAS unsigned char* lds, const LAS float* scl, int tid) {
#pragma unroll
    for (int i = 0; i < 4; ++i) {
        const int u = tid + 512 * i;
        const int sp = ((u >> 9) << 4) | (u & 15), ch = (u >> 4) & 31;
        const v4u a = *(const v4u*)(HB + (size_t)(t0 + 2 * sp) * 6144 + 2048 + h * 256 + ch * 8);
        const v4u b = *(const v4u*)(HB + (size_t)(t0 + 2 * sp + 1) * 6144 + 2048 + h * 256 + ch * 8);
        float fa[8], fb[8]; unpack8(a, fa); unpack8(b, fb);
        if (scl) { const float s0 = scl[2 * sp], s1 = scl[2 * sp + 1];
#pragma unroll
            for (int e = 0; e < 8; ++e) { fa[e] *= s0; fb[e] *= s1; } }
        LAS unsigned char* vb = lds + ML_V_OFF + (ch * 8) * ML_ROW + sp * 4;
#pragma unroll
        for (int e = 0; e < 8; ++e) *(LAS unsigned*)(vb + e * ML_ROW) = pk2(fa[e], fb[e]);
    }
}

__device__ __forceinline__ void ph_mlstm_gates(const Frame& F, int j) {
    const bf16* XB = (const bf16*)(F.ws + WS_XB); const bf16* WGB = (const bf16*)(F.ws + WS_WGB) + (size_t)j * 16 * 2048; float* GA = (float*)(F.ws + WS_GA);
    const int lane = fresh_lane(), l15 = lane & 15, g = lane >> 4;
    for (int task = F.gw; task < T / 16; task += F.ngw) {
        const bf16* xa = XB + (size_t)(task * 16 + l15) * D + 8 * g;
        const bf16* wb = WGB + (size_t)l15 * 2048 + 8 * g;
        f32x4 a0 = (f32x4){0.f, 0.f, 0.f, 0.f}, a1 = a0;
#pragma unroll 4
        for (int st = 0; st < 64; st += 2) {
            a0 = __builtin_amdgcn_mfma_f32_16x16x32_bf16(*(const bf16x8*)(xa + 32 * st), *(const bf16x8*)(wb + 32 * st), a0, 0, 0, 0);
            a1 = __builtin_amdgcn_mfma_f32_16x16x32_bf16(*(const bf16x8*)(xa + 32 * st + 32), *(const bf16x8*)(wb + 32 * st + 32), a1, 0, 0, 0);
        }
#pragma unroll
        for (int i = 0; i < 4; ++i) GA[(size_t)(task * 16 + 4 * g + i) * 16 + l15] = a0[i] + a1[i];
    }
}
__device__ __forceinline__ void ph_mlstm_local(const Frame& F, int j) {
    const bf16* HB = (const bf16*)(F.ws + WS_HB); const float* GA = (const float*)(F.ws + WS_GA);
    const float* gb = F.odd_gate_bias + j * 16;
    unsigned char* ml = F.ws + WS_ML;
    float* BCUM = (float*)(ml + ML_BCUM); float* IPRE = (float*)(ml + ML_IPRE); float* NLOC = (float*)(ml + ML_NLOC);
    float* BTOT = (float*)(ml + ML_BTOT); float* MLOC = (float*)(ml + ML_MLOC); bf16* CLOC = (bf16*)(F.ws + WS_CL);
    LAS unsigned char* lds = F.lds;
    LAS float* lf = (LAS float*)(lds + ML_SM_OFF); LAS float* bc = lf + 128; LAS float* wl = lf + 256; LAS float* al = lf + 384; LAS float* gi = lf + 512;
    const int tid = (F.wave * 64 + fresh_lane()), lane = tid & 63, wave = F.wave, l15 = lane & 15, g = lane >> 4;
    const float ksc = 0.08838834764831845f;
    for (int item = F.bid; item < 1024; item += F.nwg) {
        const int b = item / 512, h = (item / 64) % 8, c = item % 64;
        const int t0 = b * S + c * 128;
        __syncthreads();
        if (tid < 128) { const float* ga = GA + (size_t)(t0 + tid) * 16; gi[tid] = ga[h] + gb[h]; lf[tid] = logsig(ga[8 + h] + gb[8 + h]); }
        __syncthreads();
        {
            float a = (tid < 128) ? lf[tid] : 0.f;
#pragma unroll
            for (int d = 1; d < 64; d <<= 1) { const float o = __builtin_bit_cast(float, shl_i(__builtin_bit_cast(int, a), lane - d)); if (lane >= d) a += o; }
            if (tid == 63) wl[0] = a;
            __syncthreads();
            if (tid >= 64 && tid < 128) a += wl[0];
            if (tid < 128) bc[tid] = a;
        }
        __syncthreads();
        const float btot = bc[127];
        float wlv = -INFINITY;
        if (tid < 128) wlv = btot - bc[tid] + gi[tid];
        {   const float wm = wave_max(wlv); if (lane == 0 && wave < 2) wl[wave] = wm; }
        __syncthreads();
        const float mlv = fmaxf(wl[0], wl[1]);
        if (tid < 128) { al[tid] = __expf(wlv - mlv) * ksc; BCUM[(size_t)item * 128 + tid] = bc[tid]; IPRE[(size_t)item * 128 + tid] = gi[tid]; }
        if (tid == 0) { BTOT[item] = btot; MLOC[item] = mlv; }
        __syncthreads();
#pragma unroll
        for (int i = 0; i < 2; ++i) {
            const int u = tid + 512 * i;
            const int sp = ((u >> 8) << 4) | (u & 15), ch = (u >> 4) & 15;
            const v4u a = *(const v4u*)(HB + (size_t)(t0 + 2 * sp) * 6144 + 1024 + h * 128 + ch * 8);
            const v4u bq = *(const v4u*)(HB + (size_t)(t0 + 2 * sp + 1) * 6144 + 1024 + h * 128 + ch * 8);
            LAS unsigned char* kb = lds + ML_K_OFF + (ch * 8) * ML_ROW + sp * 4;
            *(LAS unsigned*)(kb + 0 * ML_ROW) = (a.x & 0xffffu) | (bq.x << 16);      *(LAS unsigned*)(kb + 1 * ML_ROW) = (a.x >> 16) | (bq.x & 0xffff0000u);
            *(LAS unsigned*)(kb + 2 * ML_ROW) = (a.y & 0xffffu) | (bq.y << 16);      *(LAS unsigned*)(kb + 3 * ML_ROW) = (a.y >> 16) | (bq.y & 0xffff0000u);
            *(LAS unsigned*)(kb + 4 * ML_ROW) = (a.z & 0xffffu) | (bq.z << 16);      *(LAS unsigned*)(kb + 5 * ML_ROW) = (a.z >> 16) | (bq.z & 0xffff0000u);
            *(LAS unsigned*)(kb + 6 * ML_ROW) = (a.w & 0xffffu) | (bq.w << 16);      *(LAS unsigned*)(kb + 7 * ML_ROW) = (a.w >> 16) | (bq.w & 0xffff0000u);
        }
        ml_stage_vt(HB, t0, h, lds, al, tid);
        __syncthreads();
        bf16x8 bfr[2][4];
#pragma unroll
        for (int vt = 0; vt < 2; ++vt)
#pragma unroll
            for (int st = 0; st < 4; ++st) bfr[vt][st] = *(const LAS bf16x8*)(lds + ML_V_OFF + (16 * (2 * wave + vt) + l15) * ML_ROW + 16 * g + 64 * st);
#pragma unroll
        for (int kt = 0; kt < 8; ++kt) {
            f32x4 c0 = (f32x4){0.f, 0.f, 0.f, 0.f}, c1 = (f32x4){0.f, 0.f, 0.f, 0.f};
#pragma unroll
            for (int st = 0; st < 4; ++st) {
                const bf16x8 af = *(const LAS bf16x8*)(lds + ML_K_OFF + (16 * kt + l15) * ML_ROW + 16 * g + 64 * st);
                c0 = __builtin_amdgcn_mfma_f32_16x16x32_bf16(af, bfr[0][st], c0, 0, 0, 0);
                c1 = __builtin_amdgcn_mfma_f32_16x16x32_bf16(af, bfr[1][st], c1, 0, 0, 0);
            }
            bf16* cp = CLOC + ((size_t)item * 256 + 16 * (2 * wave) + l15) * 128 + 16 * kt + 4 * g;
            v2u w0; w0.x = pk2(c0[0], c0[1]); w0.y = pk2(c0[2], c0[3]); *(v2u*)cp = w0;
            v2u w1; w1.x = pk2(c1[0], c1[1]); w1.y = pk2(c1[2], c1[3]); *(v2u*)(cp + 16 * 128) = w1;
        }
        if (tid < 128) {
            float n = 0.f;
            const LAS unsigned* kr = (const LAS unsigned*)(lds + ML_K_OFF + tid * ML_ROW);
            for (int sp = 0; sp < 64; ++sp) { const unsigned w = kr[sp]; n += al[2 * sp] * bflo(w) + al[2 * sp + 1] * bfhi(w); }
            NLOC[(size_t)item * 128 + tid] = n;
        }
    }
}

__device__ __forceinline__ void ph_mlstm_scan(const Frame& F) {
    unsigned char* ml = F.ws + WS_ML;
    float* NLOC = (float*)(ml + ML_NLOC); const float* BTOT = (const float*)(ml + ML_BTOT); const float* MLOC = (const float*)(ml + ML_MLOC);
    float* MPREV = (float*)(ml + ML_MPREV); unsigned* CL2 = (unsigned*)(F.ws + WS_CL);
    const int nthr = F.nwg * NTHREADS;
    for (int idx = F.bid * NTHREADS + (F.wave * 64 + fresh_lane()); idx < 16 * 16384; idx += nthr) {
        const int bh = idx / 16384, e = idx % 16384;
        const bool do_n = e < 128;
        float c0 = 0.f, c1 = 0.f, n = 0.f, m = 0.f;
#pragma unroll 1
        for (int ch0 = 0; ch0 < 64; ch0 += 16) {
            unsigned cl[16]; float nl[16];
#pragma unroll
            for (int j = 0; j < 16; ++j) { cl[j] = CL2[(size_t)(bh * 64 + ch0 + j) * 16384 + e]; nl[j] = do_n ? NLOC[(size_t)(bh * 64 + ch0 + j) * 128 + e] : 0.f; }
#pragma unroll
            for (int j = 0; j < 16; ++j) {
                const int item = bh * 64 + ch0 + j;
                const float bt = BTOT[item], mlv = MLOC[item];
                const float mn = fmaxf(bt + m, mlv);
                const float ao = __expf(bt + m - mn), an = __expf(mlv - mn);
                const unsigned prev = pk2(c0, c1); const float nprev = n;
                c0 = ao * c0 + an * bflo(cl[j]); c1 = ao * c1 + an * bfhi(cl[j]); n = ao * n + an * nl[j];
                cl[j] = prev; nl[j] = nprev;
                if (e == 0) MPREV[item] = m;
                m = mn;
            }
#pragma unroll
            for (int j = 0; j < 16; ++j) { CL2[(size_t)(bh * 64 + ch0 + j) * 16384 + e] = cl[j]; if (do_n) NLOC[(size_t)(bh * 64 + ch0 + j) * 128 + e] = nl[j]; }
        }
    }
}

constexpr int MLO_Q_OFF = ML_V_OFF + 256 * ML_ROW;
static_assert(MLO_Q_OFF + 128 * ML_ROW <= RING_BYTES, "mLSTM out LDS");
__device__ __forceinline__ void mlo_issue(const bf16* HB, int item, int tid, v4u (&kq)[8], v4u (&pva)[4], v4u (&pvb)[4]) {
    const int b = item / 512, h = (item / 64) % 8, c = item % 64, t0 = b * S + c * 128;
#pragma unroll
    for (int i = 0; i < 4; ++i) { const int u = tid + 512 * i, r = u >> 4, ch = u & 15;
        kq[2 * i] = *(const v4u*)(HB + (size_t)(t0 + r) * 6144 + 1024 + h * 128 + ch * 8);
        kq[2 * i + 1] = *(const v4u*)(HB + (size_t)(t0 + r) * 6144 + h * 128 + ch * 8); }
#pragma unroll
    for (int i = 0; i < 4; ++i) { const int u = tid + 512 * i; const int sp = ((u >> 9) << 4) | (u & 15), ch = (u >> 4) & 31;
        pva[i] = *(const v4u*)(HB + (size_t)(t0 + 2 * sp) * 6144 + 2048 + h * 256 + ch * 8);
        pvb[i] = *(const v4u*)(HB + (size_t)(t0 + 2 * sp + 1) * 6144 + 2048 + h * 256 + ch * 8); }
}
__device__ __forceinline__ void ph_mlstm_out(const Frame& F) {
    const bf16* HB = (const bf16*)(F.ws + WS_HB); bf16* YB = (bf16*)(F.ws + WS_YB);
    unsigned char* ml = F.ws + WS_ML;
    const float* BCUM = (const float*)(ml + ML_BCUM); const float* IPRE = (const float*)(ml + ML_IPRE); const float* NPREV = (const float*)(ml + ML_NLOC);
    const float* MPREV = (const float*)(ml + ML_MPREV); const bf16* CPREV = (const bf16*)(F.ws + WS_CL);
    LAS unsigned char* lds = F.lds;
    LAS float* bc = (LAS float*)(lds + ML_SM_OFF); LAS float* ipr = bc + 128; LAS float* np = bc + 256; LAS float* mts = bc + 384; LAS float* dd = bc + 512; LAS float* ais = bc + 640; LAS float* rds = bc + 768;
    const int tid = (F.wave * 64 + fresh_lane()), lane = tid & 63, wave = F.wave, l15 = lane & 15, g = lane >> 4;
    const float ksc = 0.08838834764831845f;
    v4u kq[8], pva[4], pvb[4];
    if (F.bid < 1024) mlo_issue(HB, F.bid, tid, kq, pva, pvb);
    for (int item = F.bid; item < 1024; item += F.nwg) {
        const int b = item / 512, h = (item / 64) % 8, c = item % 64;
        const int t0 = b * S + c * 128;
        bf16x8 cf[2][4];
#pragma unroll
        for (int vt = 0; vt < 2; ++vt)
#pragma unroll
            for (int st = 0; st < 4; ++st) cf[vt][st] = *(const bf16x8*)(CPREV + ((size_t)item * 256 + 16 * (2 * wave + vt) + l15) * 128 + 8 * g + 32 * st);
        __syncthreads();
        if (tid < 128) { const float bv = BCUM[(size_t)item * 128 + tid], iv = IPRE[(size_t)item * 128 + tid]; bc[tid] = bv; ipr[tid] = iv; dd[tid] = iv - bv; np[tid] = NPREV[(size_t)item * 128 + tid]; }
        const float mprev = MPREV[item];
#pragma unroll
        for (int i = 0; i < 4; ++i) {
            const int u = tid + 512 * i, r = u >> 4, ch = u & 15;
            *(LAS v4u*)(lds + ML_K_OFF + r * ML_ROW + ch * 16) = kq[2 * i];
            *(LAS v4u*)(lds + MLO_Q_OFF + r * ML_ROW + ch * 16) = kq[2 * i + 1];
        }
#pragma unroll
        for (int i = 0; i < 4; ++i) {
            const int u = tid + 512 * i; const int sp = ((u >> 9) << 4) | (u & 15), ch = (u >> 4) & 31;
            const v4u a = pva[i], bq = pvb[i];
            LAS unsigned char* vbp = lds + ML_V_OFF + (ch * 8) * ML_ROW + sp * 4;
            *(LAS unsigned*)(vbp + 0 * ML_ROW) = (a.x & 0xffffu) | (bq.x << 16);      *(LAS unsigned*)(vbp + 1 * ML_ROW) = (a.x >> 16) | (bq.x & 0xffff0000u);
            *(LAS unsigned*)(vbp + 2 * ML_ROW) = (a.y & 0xffffu) | (bq.y << 16);      *(LAS unsigned*)(vbp + 3 * ML_ROW) = (a.y >> 16) | (bq.y & 0xffff0000u);
            *(LAS unsigned*)(vbp + 4 * ML_ROW) = (a.z & 0xffffu) | (bq.z << 16);      *(LAS unsigned*)(vbp + 5 * ML_ROW) = (a.z >> 16) | (bq.z & 0xffff0000u);
            *(LAS unsigned*)(vbp + 6 * ML_ROW) = (a.w & 0xffffu) | (bq.w << 16);      *(LAS unsigned*)(vbp + 7 * ML_ROW) = (a.w >> 16) | (bq.w & 0xffff0000u);
        }
        __syncthreads();
        {
            float pm = (tid < 128) ? dd[tid] : -INFINITY;
#pragma unroll
            for (int d = 1; d < 64; d <<= 1) { const float o = __builtin_bit_cast(float, shl_i(__builtin_bit_cast(int, pm), lane - d)); if (lane >= d) pm = fmaxf(pm, o); }
            if (tid == 63) ais[0] = pm;
            __syncthreads();
            if (tid >= 64 && tid < 128) pm = fmaxf(pm, ais[0]);
            if (tid < 128) mts[tid] = fmaxf(bc[tid] + mprev, bc[tid] + pm);
        }
        __syncthreads();
        const int tq = 16 * wave + l15;
        v2u pw[8];
        {
            bf16x8 qf[4];
#pragma unroll
            for (int st = 0; st < 4; ++st) qf[st] = *(const LAS bf16x8*)(lds + MLO_Q_OFF + tq * ML_ROW + 16 * g + 64 * st);
            const float bct = bc[tq], mt = mts[tq];
            const float ai = __expf(bct + mprev - mt);
            float dsum = 0.f;
#pragma unroll
            for (int kt = 0; kt < 8; ++kt) {
                f32x4 sa = (f32x4){0.f, 0.f, 0.f, 0.f};
                if (kt <= wave) {
#pragma unroll
                    for (int st = 0; st < 4; ++st) sa = __builtin_amdgcn_mfma_f32_16x16x32_bf16(*(const LAS bf16x8*)(lds + ML_K_OFF + (16 * kt + l15) * ML_ROW + 16 * g + 64 * st), qf[st], sa, 0, 0, 0);
                    const f32x4 d4 = *(const LAS f32x4*)&dd[16 * kt + 4 * g];
#pragma unroll
                    for (int i = 0; i < 4; ++i) { const int s = 16 * kt + 4 * g + i; const float v = (s <= tq) ? sa[i] * ksc * __expf(bct + d4[i] - mt) : 0.f; sa[i] = v; dsum += v; }
                }
                pw[kt].x = pk2(sa[0], sa[1]); pw[kt].y = pk2(sa[2], sa[3]);
            }
            dsum = xrow_sum(dsum);
            float nq = 0.f;
#pragma unroll
            for (int st = 0; st < 4; ++st) { float qv[8]; unpack8(__builtin_bit_cast(v4u, qf[st]), qv);
                const f32x4 n0 = *(const LAS f32x4*)&np[32 * st + 8 * g], n1 = *(const LAS f32x4*)&np[32 * st + 8 * g + 4];
                nq += qv[0] * n0[0] + qv[1] * n0[1] + qv[2] * n0[2] + qv[3] * n0[3] + qv[4] * n1[0] + qv[5] * n1[1] + qv[6] * n1[2] + qv[7] * n1[3]; }
            nq = xrow_sum(nq);
            const float den = ai * nq + dsum;
            if (g == 0) { ais[tq] = ai; rds[tq] = 1.0f / fmaxf(fabsf(den), __expf(-mt)); }
        }
        __syncthreads();
#pragma unroll
        for (int kt = 0; kt < 8; ++kt) *(LAS v2u*)(lds + ML_K_OFF + tq * ML_ROW + (16 * kt + 4 * g) * 2) = pw[kt];
        __syncthreads();
        if (item + F.nwg < 1024) mlo_issue(HB, item + F.nwg, tid, kq, pva, pvb);
        const bf16* ogp = HB + (size_t)(t0 + l15) * 6144 + 4096 + h * 256 + 32 * wave + 4 * g;
        v2u ogn0 = *(const v2u*)ogp, ogn1 = *(const v2u*)(ogp + 16);
#pragma unroll
        for (int tt = 0; tt < 8; ++tt) {
            const int t = 16 * tt + l15;
            const v2u ogc[2] = {ogn0, ogn1};
            if (tt < 7) { ogn0 = *(const v2u*)(ogp + (size_t)(16 * (tt + 1)) * 6144); ogn1 = *(const v2u*)(ogp + (size_t)(16 * (tt + 1)) * 6144 + 16); }
            bf16x8 qf[4];
#pragma unroll
            for (int st = 0; st < 4; ++st) qf[st] = *(const LAS bf16x8*)(lds + MLO_Q_OFF + t * ML_ROW + 16 * g + 64 * st);
            const int nst = (tt >> 1) + 1;
            bf16x8 pf[4];
#pragma unroll
            for (int st = 0; st < 4; ++st) if (st < nst) pf[st] = *(const LAS bf16x8*)(lds + ML_K_OFF + t * ML_ROW + 16 * g + 64 * st);
            const float ai = ais[t], rd = rds[t];
#pragma unroll
            for (int vt = 0; vt < 2; ++vt) {
                f32x4 ci = (f32x4){0.f, 0.f, 0.f, 0.f}, cx = (f32x4){0.f, 0.f, 0.f, 0.f};
#pragma unroll
                for (int st = 0; st < 4; ++st) ci = __builtin_amdgcn_mfma_f32_16x16x32_bf16(cf[vt][st], qf[st], ci, 0, 0, 0);
                const LAS unsigned char* vr = lds + ML_V_OFF + (16 * (2 * wave + vt) + l15) * ML_ROW + 16 * g;
#pragma unroll
                for (int st = 0; st < 4; ++st) if (st < nst) cx = __builtin_amdgcn_mfma_f32_16x16x32_bf16(*(const LAS bf16x8*)(vr + 64 * st), pf[st], cx, 0, 0, 0);
                const int vcol = h * 256 + 16 * (2 * wave + vt) + 4 * g;
                const v2u ogw = ogc[vt];
                const float y0 = (ai * ci[0] + cx[0]) * rd * sigmoidf_(bflo(ogw.x)), y1 = (ai * ci[1] + cx[1]) * rd * sigmoidf_(bfhi(ogw.x));
                const float y2 = (ai * ci[2] + cx[2]) * rd * sigmoidf_(bflo(ogw.y)), y3 = (ai * ci[3] + cx[3]) * rd * sigmoidf_(bfhi(ogw.y));
                v2u w; w.x = pk2(y0, y1); w.y = pk2(y2, y3);
                *(v2u*)(YB + (size_t)(t0 + t) * 2048 + vcol) = w;
            }
        }
    }
}
struct Args { const void* in[17]; float* out; unsigned char* ws; int ph_lo, ph_hi; };
constexpr int PH_PER_LAYER = 9, N_PHASES = 1 + 4 * PH_PER_LAYER;

__global__ void __launch_bounds__(NTHREADS, 2) mk_fwd(Args args) {
    extern __shared__ __attribute__((aligned(16))) unsigned char lds_raw[];
    Frame F0;
#define F F0
    F.lds = (LAS unsigned char*)lds_raw;
    F.tid = threadIdx.x; F.lane = F.tid & 63; F.wave = __builtin_amdgcn_readfirstlane(F.tid >> 6);
    F.gw = blockIdx.x * NWAVES + F.wave; F.ngw = gridDim.x * NWAVES; F.bid = (int)blockIdx.x; F.nwg = (int)gridDim.x;
    F.x = (const float*)args.in[0]; F.p = (const float*)args.in[1]; F.pos = (const int*)args.in[2];
    F.even_w_in = (const float*)args.in[3]; F.even_conv_w = (const float*)args.in[4]; F.even_w_out = (const float*)args.in[5];
    F.odd_w_in = (const float*)args.in[6]; F.odd_gate_bias = (const float*)args.in[7]; F.odd_w_out = (const float*)args.in[8];
    F.peer_w_q = (const float*)args.in[9]; F.peer_sub_keys = (const float*)args.in[10]; F.peer_u = (const float*)args.in[11]; F.peer_v = (const float*)args.in[12];
    F.ple_w_proj = (const float*)args.in[13]; F.ple_w_gate = (const float*)args.in[14]; F.ln_gain = (const float*)args.in[15]; F.ln_bias = (const float*)args.in[16];
    F.out = args.out; F.ws = args.ws;
    unsigned char* ws0_ = args.ws;
    for (int u = F.tid; u < (LDS_BYTES - LDSCTL_OFF) / 4; u += NTHREADS) ((LAS unsigned*)(F.lds + LDSCTL_OFF))[u] = 0u;
    __syncthreads();
    XcdBarrier bar = xcd_barrier_post((unsigned*)(ws0_ + WS_CTL) + CW_BAR, (volatile LAS unsigned*)(F.lds + MISC_OFF) + 8);
    const int lo = args.ph_lo, hi = args.ph_hi;
#ifndef PROBE_REP_MASK
#define PROBE_REP_MASK 0
#endif
#define PH_REP(k) for (int rep_ = 0; rep_ < (((PROBE_REP_MASK >> (k)) & 1) ? 2 : 1); ++rep_)
#define PH_IN(id) (lo <= (id) && (id) < hi)
#define PH_SEAM(id) do { if ((id) + 1 < hi) xcd_barrier(bar, F.wave == 0 && fresh_lane() == 0); } while (0)

#if MK_FP8_INPROJ
    if (PH_IN(0)) { p0_prologue(F); xcd_barrier(bar, F.wave == 0 && fresh_lane() == 0); p0_prologue_b(F); PH_SEAM(0); }
#else
    if (PH_IN(0)) { PH_REP(9) { p0_prologue(F); } PH_SEAM(0); }
#endif
#undef F

    for (int layer_ = 0; layer_ < DEPTH; ++layer_) {
        int layer = layer_; asm volatile("" : "+s"(layer));
        GAS unsigned char* wsg_ = (GAS unsigned char*)args.ws; asm volatile("" : "+s"(wsg_));
        unsigned char* wsl_ = (unsigned char*)wsg_;
        Frame FL = F0; FL.ws = wsl_;
        asm volatile("" : "+s"(FL.bid), "+s"(FL.nwg), "+s"(FL.wave));
        FL.gw = FL.bid * NWAVES + FL.wave; FL.ngw = FL.nwg * NWAVES;
        const Frame& F = FL; unsigned char* const ws = wsl_;
        const int pb = 1 + layer * PH_PER_LAYER;
        const int j = layer >> 1;
        const bool even = (layer & 1) == 0;
        if (PH_IN(pb + 0)) { PH_REP(0) {
#if MK_FP8_INPROJ
            { pg8::Gemm g{(const bf16*)(ws + WS_X8), (const bf16*)(ws + WS_WIN + (size_t)layer * 6144 * 2048), T, 6144, 1024};
              pg8::StaticOrder So; So.init(T, 6144, F.nwg, F.bid);
              EpiPlainI8 E{(bf16*)(ws + WS_HB), 6144, (const float*)(ws + WS_SX), (const float*)(ws + WS_SW) + layer * 6144};
              pg8::gemm_phase<EpiPlainI8, pg8::StaticOrder, true, true, true>(F.lds + RING_OFF, g, So, E, F.wave * 64 + fresh_lane()); }
#else
            { pg8::Gemm g{(const bf16*)(ws + WS_XB), (const bf16*)(ws + WS_WIN) + (size_t)layer * 6144 * 2048, T, 6144, 2048};
              pg8::StaticOrder So; So.init(T, 6144, F.nwg, F.bid);
              EpiPlain E{(bf16*)(ws + WS_HB), 6144};
              pg8::gemm_phase<EpiPlain, pg8::StaticOrder, true, true>(F.lds + RING_OFF, g, So, E, F.wave * 64 + fresh_lane()); }
#endif
            { pg8::Gemm g{(const bf16*)(ws + WS_PB) + (size_t)layer * T * 256, (const bf16*)(ws + WS_WPJ) + (size_t)layer * 2048 * 256, T, 2048, 256};
              pg8::StaticOrder So; So.init(T, 2048, F.nwg, F.bid);
              EpiPlain E{(bf16*)(ws + WS_PJ), 2048};
              pg8::gemm_phase<EpiPlain, pg8::StaticOrder, true, true>(F.lds + RING_OFF, g, So, E, F.wave * 64 + fresh_lane()); }
            if (!even) ph_mlstm_gates(F, j);
            ph_c12(F, layer); }
            PH_SEAM(pb + 0);
        }
        if (even) {
            if (PH_IN(pb + 1)) { ph_rope_conv(F, j); PH_SEAM(pb + 1); }
            if (PH_IN(pb + 2)) { PH_REP(2) { ph_attn_mfma(F); } PH_SEAM(pb + 2); }
            if (PH_IN(pb + 3)) { PH_REP(10) { ph_attn_combine(F); } PH_SEAM(pb + 3); }
        } else {
            if (PH_IN(pb + 1)) { PH_REP(1) { ph_mlstm_local(F, j); } PH_SEAM(pb + 1); }
            if (PH_IN(pb + 2)) { ph_mlstm_scan(F); PH_SEAM(pb + 2); }
#if MK_FP8_INPROJ
            if (PH_IN(pb + 3)) { ph_mlstm_out(F); xcd_barrier(bar, F.wave == 0 && fresh_lane() == 0); ph_quant_y(F); PH_SEAM(pb + 3); }
#else
            if (PH_IN(pb + 3)) { PH_REP(3) { ph_mlstm_out(F); } PH_SEAM(pb + 3); }
#endif
        }
#if MK_FP8_INPROJ
        if (PH_IN(pb + 4)) {
            pg8::Gemm g{(const bf16*)(ws + WS_Y8), (const bf16*)(ws + WS_WOUT + (size_t)layer * 2048 * 2048), T, 2048, 1024};
            pg8::StaticOrder So; So.init(T, 2048, F.nwg, F.bid);
            EpiZ8 E{(bf16*)(ws + WS_ZF), (const float*)nullptr, (const bf16*)(ws + WS_XB), (const float*)(ws + WS_SY), (const float*)(ws + WS_SWO) + (size_t)layer * 2048};
            pg8::gemm_phase<EpiZ8, pg8::StaticOrder, true, true, true>(F.lds + RING_OFF, g, So, E, F.wave * 64 + fresh_lane());
            PH_SEAM(pb + 4);
        }
#else
        if (PH_IN(pb + 4)) {
            pg8::Gemm g{(const bf16*)(ws + WS_YB), (const bf16*)(ws + WS_WOUT) + (size_t)layer * 2048 * 2048, T, 2048, 2048};
            pg8::StaticOrder So; So.init(T, 2048, F.nwg, F.bid);
            EpiZ E{(bf16*)(ws + WS_ZF), (layer == 0) ? F.x : (const float*)nullptr, (const bf16*)(ws + WS_XB), (float*)(ws + WS_PST)};
            PH_REP(4) { pg8::gemm_phase<EpiZ, pg8::StaticOrder, true, true>(F.lds + RING_OFF, g, So, E, F.wave * 64 + fresh_lane()); }
            PH_SEAM(pb + 4);
        }
#endif
#if MK_FP8_INPROJ
        if (PH_IN(pb + 5)) { ph_quant_z(F, layer); PH_SEAM(pb + 5); }
        if (PH_IN(pb + 6)) {
            pg8::Gemm g{(const bf16*)(ws + WS_Z8), (const bf16*)(ws + WS_WQG + (size_t)layer * 4096 * 2048), T, 4096, 1024};
            pg8::StaticOrder So; So.init(T, 4096, F.nwg, F.bid);
            EpiQG8 E{(bf16*)(ws + WS_QB), (const bf16*)(ws + WS_PJ), (bf16*)(ws + WS_PLE), (const float*)(ws + WS_C12) + (size_t)layer * 4096 * 2, (const float*)(ws + WS_RS), (const float*)(ws + WS_SWQ) + (size_t)layer * 4096};
            pg8::gemm_phase<EpiQG8, pg8::StaticOrder, true, true, true>(F.lds + RING_OFF, g, So, E, F.wave * 64 + fresh_lane());
            PH_SEAM(pb + 6);
        }
#else
        if (PH_IN(pb + 6)) {
            pg8::Gemm g{(const bf16*)(ws + WS_ZF), (const bf16*)(ws + WS_WQG) + (size_t)layer * 4096 * 2048, T, 4096, 2048};
            pg8::StaticOrder So; So.init(T, 4096, F.nwg, F.bid);
            int pmr0, pmr1, pmr2; ln1_row_stats(F, So, pmr0, pmr1, pmr2);
            EpiQG E{(bf16*)(ws + WS_QB), (const bf16*)(ws + WS_PJ), (bf16*)(ws + WS_PLE), (const float*)(ws + WS_C12) + (size_t)layer * 4096 * 2, (LAS const float*)(F.lds + STAT_OFF), pmr0, pmr1, pmr2};
            PH_REP(6) { pg8::gemm_phase<EpiQG, pg8::StaticOrder, true, true>(F.lds + RING_OFF, g, So, E, F.wave * 64 + fresh_lane()); }
            PH_SEAM(pb + 6);
        }
#endif
        if (PH_IN(pb + 7)) { PH_REP(7) { ph_topk(F, layer); } PH_SEAM(pb + 7); }
#ifdef PROBE_GATHER_MASK
        if (PH_IN(pb + 8)) { ph_gather_ln2(F, layer, 1); __syncthreads(); ph_gather_ln2(F, layer, 0); PH_SEAM(pb + 8); }
#else
        if (PH_IN(pb + 8)) { PH_REP(8) { ph_gather_ln2(F, layer); } PH_SEAM(pb + 8); }
#endif
    }
#undef PH_IN
#undef PH_SEAM
}

#ifndef MK_ONE_LAUNCH
#define MK_ONE_LAUNCH 1
#endif
static void run(void* const* d_in, float* out, unsigned char* ws, size_t ws_size, hipStream_t stream) {
    static int ready = 0, grid = 256;
    if (!ready) {
        if (ws_size < WS_END) { fprintf(stderr, "mk: workspace too small (%zu < %zu)\n", ws_size, (size_t)WS_END); ready = -1; return; }
        if (hipFuncSetAttribute((const void*)mk_fwd, hipFuncAttributeMaxDynamicSharedMemorySize, LDS_BYTES) != hipSuccess) { fprintf(stderr, "mk: hipFuncSetAttribute failed\n"); ready = -1; return; }
        int dev = 0, cus = 0;
        if (hipGetDevice(&dev) == hipSuccess && hipDeviceGetAttribute(&cus, hipDeviceAttributeMultiprocessorCount, dev) == hipSuccess && cus > 0 && cus < 256) grid = (cus / 8) * 8 > 0 ? (cus / 8) * 8 : cus;
        (void)hipGetLastError();
        ready = 1;
    }
    if (ready < 0) return;
    (void)hipMemsetAsync(ws + WS_CTL, 0, CTL_ZERO_BYTES, stream);
    Args a; memset(&a, 0, sizeof(a));
    for (int i = 0; i < 17; ++i) a.in[i] = d_in[i];
    a.out = out; a.ws = ws;
#if MK_ONE_LAUNCH
    a.ph_lo = 0; a.ph_hi = N_PHASES;
    hipLaunchKernelGGL(mk_fwd, dim3(grid), dim3(NTHREADS), LDS_BYTES, stream, a);
#else
    for (int ph = 0; ph < N_PHASES; ++ph) {
        if (ph > 0) { const int layer = (ph - 1) / PH_PER_LAYER, k = (ph - 1) % PH_PER_LAYER;  }
        a.ph_lo = ph; a.ph_hi = ph + 1;
        hipLaunchKernelGGL(mk_fwd, dim3(grid), dim3(NTHREADS), LDS_BYTES, stream, a);
    }
#endif
    const hipError_t le = hipPeekAtLastError();
    if (le != hipSuccess) fprintf(stderr, "mk: launch failed: %s\n", hipGetErrorName(le));
}
}

extern "C" void kernel_launch(void* const* d_in, const int* in_sizes, int n_in,
                              void* d_out, int out_size, void* d_ws, size_t ws_size,
                              hipStream_t stream) {
    (void)in_sizes; (void)n_in; (void)out_size;
    mk::run(d_in, (float*)d_out, (unsigned char*)d_ws, ws_size, stream);
}
```
